# Optimizing an MI355X kernel written in HIP

```python
import math
import jax, jax.numpy as jnp
from jax import lax
import numpy as np

D_MODEL = 2048
BATCH = 8
SEQ = 2048
DEPTH = 1

M_HEADS = 4
M_DH = 256
M_W = M_HEADS * M_DH
CONV_K = 4
CHUNK = 64
A_HEADS = 8
A_NOPE = 128
A_ROPE = 64
A_DV = 128
A_DQK = A_NOPE + A_ROPE
A_W = A_HEADS * A_DV
Q_LORA = 512
KV_LORA = 512
ROPE_THETA = 10000.0
Q_BLOCK = 128
N_MEM = 256
C_HEADS = 4
C_DH = 256
C_W = C_HEADS * C_DH
N_BRANCH = 3
EPS = 1e-6

IN_SPLITS = (2 * M_W, M_W, M_W, M_W, M_HEADS, M_HEADS,
             Q_LORA, KV_LORA, A_ROPE, A_W,
             C_W, C_W,
             N_BRANCH * D_MODEL)
IN_DIM = sum(IN_SPLITS)

kernel_name = "hybrid_mlstm_mla_memory_gated"


def rms_norm(x, g):
    xf = x.astype(jnp.float32)
    y = xf * lax.rsqrt(jnp.mean(xf * xf, axis=-1, keepdims=True) + EPS)
    return (y * g.astype(jnp.float32)).astype(x.dtype)


def split_cols(z):
    idx = np.cumsum(IN_SPLITS)[:-1].tolist()
    return jnp.split(z, idx, axis=-1)


def causal_depthwise_conv(x, w, b):
    S = x.shape[1]
    xp = jnp.pad(x, ((0, 0), (CONV_K - 1, 0), (0, 0)))
    y = b
    for j in range(CONV_K):
        y = y + w[j] * xp[:, j:j + S]
    return y


def apply_rope(x, cos, sin):
    xf = x.astype(jnp.float32)
    half = xf.shape[-1] // 2
    x1, x2 = xf[..., :half], xf[..., half:]
    return jnp.concatenate([x1 * cos - x2 * sin, x2 * cos + x1 * sin], axis=-1).astype(x.dtype)


def mlstm_chunkwise(q, k, v, ig, lf):
    B, S, H, d = q.shape
    nc = S // CHUNK

    def chunks4(t):
        return t.reshape(B, nc, CHUNK, H, t.shape[-1]).transpose(1, 0, 3, 2, 4)

    def chunks3(t):
        return t.reshape(B, nc, CHUNK, H).transpose(1, 0, 3, 2)

    tril = jnp.tril(jnp.ones((CHUNK, CHUNK), dtype=bool))

    def step(carry, xs):
        C, n, m = carry
        qc, kc, vc, ic, fc = xs
        b = jnp.cumsum(fc, axis=-1)
        g = b[..., -1]
        dmat = jnp.where(tril, b[..., :, None] - b[..., None, :] + ic[..., None, :], -jnp.inf)
        inter = b + m[..., None]
        m_t = jnp.maximum(inter, jnp.max(dmat, axis=-1))
        w_intra = jnp.exp(dmat - m_t[..., None])
        w_inter = jnp.exp(inter - m_t)
        s = jnp.einsum('bhtd,bhsd->bhts', qc, kc) * w_intra
        num = (w_inter[..., None] * jnp.einsum('bhtk,bhkv->bhtv', qc, C)
               + jnp.einsum('bhts,bhsv->bhtv', s, vc))
        den = w_inter * jnp.einsum('bhtk,bhk->bht', qc, n) + jnp.sum(s, axis=-1)
        h = num / jnp.maximum(jnp.abs(den), jnp.exp(-m_t))[..., None]
        a = g[..., None] - b + ic
        m_new = jnp.maximum(g + m, jnp.max(a, axis=-1))
        w_s = jnp.exp(a - m_new[..., None])
        decay = jnp.exp(g + m - m_new)
        C_new = decay[..., None, None] * C + jnp.einsum('bhs,bhsk,bhsv->bhkv', w_s, kc, vc)
        n_new = decay[..., None] * n + jnp.einsum('bhs,bhsk->bhk', w_s, kc)
        return (C_new, n_new, m_new), h

    init = (jnp.zeros((B, H, d, d), jnp.float32),
            jnp.zeros((B, H, d), jnp.float32),
            jnp.zeros((B, H), jnp.float32))
    xs = (chunks4(q), chunks4(k), chunks4(v), chunks3(ig), chunks3(lf))
    _, h = lax.scan(step, init, xs)
    return h.transpose(1, 0, 3, 2, 4).reshape(B, S, H, d)


def causal_block_attention(q, k, v):
    B, S, H, dqk = q.shape
    dv = v.shape[-1]
    nb = S // Q_BLOCK
    scale = 1.0 / math.sqrt(dqk)
    qb = q.reshape(B, nb, Q_BLOCK, H, dqk).transpose(1, 0, 3, 2, 4)
    k_pos = jnp.arange(S)

    def attend(args):
        qi, blk = args
        s = jnp.einsum('bhqd,bshd->bhqs', qi, k).astype(jnp.float32) * scale
        q_pos = blk * Q_BLOCK + jnp.arange(Q_BLOCK)
        s = jnp.where(k_pos[None, :] <= q_pos[:, None], s, -jnp.inf)
        p = jax.nn.softmax(s, axis=-1)
        return jnp.einsum('bhqs,bshd->bqhd', p.astype(v.dtype), v)

    out = lax.map(attend, (qb, jnp.arange(nb)))
    return out.transpose(1, 0, 2, 3, 4).reshape(B, S, H * dv)


def memory_attention(q, k, v):
    B, S, H, d = q.shape
    s = jnp.einsum('bshd,bmhd->bhsm', q, k).astype(jnp.float32) * (1.0 / math.sqrt(d))
    p = jax.nn.softmax(s, axis=-1)
    return jnp.einsum('bhsm,bmhd->bshd', p.astype(v.dtype), v).reshape(B, S, H * d)


def setup_inputs(seed: int = 0) -> dict:
    key = jax.random.key(seed)
    ks = jax.random.split(key, 24)
    f32 = jnp.float32

    def nrm(k, shape, fan_in):
        return jax.random.normal(k, shape, f32) * (fan_in ** -0.5)

    def gain(k, shape):
        return 1.0 + 0.02 * jax.random.normal(k, shape, f32)

    x = jax.random.normal(ks[0], (BATCH, SEQ, D_MODEL), f32)
    mem = jax.random.normal(ks[1], (BATCH, N_MEM, D_MODEL), f32)
    start = jax.random.randint(ks[2], (BATCH, 1), 0, 4096, dtype=jnp.int32)
    positions = start + jnp.arange(SEQ, dtype=jnp.int32)[None, :]
    return {
        "x": x,
        "mem": mem,
        "positions": positions,
        "w_in": nrm(ks[3], (DEPTH, D_MODEL, IN_DIM), D_MODEL),
        "b_igate": 0.1 * jax.random.normal(ks[4], (DEPTH, M_HEADS), f32),
        "b_fgate": 3.0 + 3.0 * jax.random.uniform(ks[5], (DEPTH, M_HEADS), f32),
        "conv_w": nrm(ks[6], (DEPTH, CONV_K, 2 * M_W), CONV_K),
        "conv_b": 0.02 * jax.random.normal(ks[7], (DEPTH, 2 * M_W), f32),
        "mh_norm": gain(ks[8], (DEPTH, M_W)),
        "cq_norm": gain(ks[9], (DEPTH, Q_LORA)),
        "w_uq": nrm(ks[10], (DEPTH, Q_LORA, A_HEADS * A_DQK), Q_LORA),
        "ckv_norm": gain(ks[11], (DEPTH, KV_LORA)),
        "w_ukv": nrm(ks[12], (DEPTH, KV_LORA, A_HEADS * (A_NOPE + A_DV)), KV_LORA),
        "mem_norm": gain(ks[13], (DEPTH, D_MODEL)),
        "w_mem_kv": nrm(ks[14], (DEPTH, D_MODEL, 2 * C_W), D_MODEL),
        "w_br_m": nrm(ks[15], (DEPTH, M_W, D_MODEL), M_W),
        "w_br_a": nrm(ks[16], (DEPTH, A_W, D_MODEL), A_W),
        "w_br_c": nrm(ks[17], (DEPTH, C_W, D_MODEL), C_W),
        "w_out": nrm(ks[18], (DEPTH, D_MODEL, D_MODEL), D_MODEL),
        "norm": gain(ks[19], (DEPTH, D_MODEL)),
        "final_norm": gain(ks[20], (D_MODEL,)),
    }


def reference(x, mem, positions, w_in, b_igate, b_fgate, conv_w, conv_b, mh_norm, cq_norm, w_uq,
              ckv_norm, w_ukv, mem_norm, w_mem_kv, w_br_m, w_br_a, w_br_c, w_out, norm, final_norm):
    B, S, _ = x.shape
    f32 = jnp.float32
    inv_freq = ROPE_THETA ** (-jnp.arange(0, A_ROPE, 2, dtype=f32) / A_ROPE)
    ang = positions.astype(f32)[..., None] * inv_freq
    cos, sin = jnp.cos(ang), jnp.sin(ang)

    for l in range(DEPTH):
        h = rms_norm(x, norm[l])
        proj = h @ w_in[l]
        (m_qk, m_v, m_o, m_z, m_i, m_f,
         a_cq, a_ckv, a_kr, a_z,
         c_q, c_z, gates) = split_cols(proj)

        qk = jax.nn.silu(causal_depthwise_conv(m_qk, conv_w[l], conv_b[l]))
        mq, mk = jnp.split(qk, 2, axis=-1)
        mq = mq.reshape(B, S, M_HEADS, M_DH).astype(f32)
        mk = mk.reshape(B, S, M_HEADS, M_DH).astype(f32) * (M_DH ** -0.5)
        mv = m_v.reshape(B, S, M_HEADS, M_DH).astype(f32)
        ig = (m_i + b_igate[l]).astype(f32)
        lf = jax.nn.log_sigmoid((m_f + b_fgate[l]).astype(f32))
        hm = mlstm_chunkwise(mq, mk, mv, ig, lf)
        hm = rms_norm(hm, mh_norm[l].reshape(M_HEADS, M_DH)).reshape(B, S, M_W).astype(x.dtype)
        hm = hm * jax.nn.sigmoid(m_o) * jax.nn.silu(m_z)

        q_all = (rms_norm(a_cq, cq_norm[l]) @ w_uq[l]).reshape(B, S, A_HEADS, A_DQK)
        q_nope, q_rope = q_all[..., :A_NOPE], q_all[..., A_NOPE:]
        q_rope = apply_rope(q_rope, cos[:, :, None, :], sin[:, :, None, :])
        kv = (rms_norm(a_ckv, ckv_norm[l]) @ w_ukv[l]).reshape(B, S, A_HEADS, A_NOPE + A_DV)
        k_nope, v_a = kv[..., :A_NOPE], kv[..., A_NOPE:]
        k_rope = apply_rope(a_kr, cos, sin)
        qa = jnp.concatenate([q_nope, q_rope], axis=-1)
        ka = jnp.concatenate([k_nope, jnp.broadcast_to(k_rope[:, :, None, :], (B, S, A_HEADS, A_ROPE))], axis=-1)
        ha = causal_block_attention(qa, ka, v_a) * jax.nn.silu(a_z)

        mkv = (rms_norm(mem, mem_norm[l]) @ w_mem_kv[l]).reshape(B, N_MEM, 2, C_HEADS, C_DH)
        hc = memory_attention(c_q.reshape(B, S, C_HEADS, C_DH), mkv[:, :, 0], mkv[:, :, 1])
        hc = hc * jax.nn.silu(c_z)

        g_m = jax.nn.sigmoid(gates[..., 0:D_MODEL])
        g_a = jax.nn.sigmoid(gates[..., D_MODEL:2 * D_MODEL])
        g_c = jax.nn.sigmoid(gates[..., 2 * D_MODEL:3 * D_MODEL])
        merged = g_m * (hm @ w_br_m[l]) + g_a * (ha @ w_br_a[l]) + g_c * (hc @ w_br_c[l])
        x = x + merged @ w_out[l]

    return rms_norm(x, final_norm)
```

```cpp
#include <hip/hip_runtime.h>
#include <hip/hip_cooperative_groups.h>
#include <cstdio>
#include <cstdint>
namespace cg = cooperative_groups;
__device__ __forceinline__ int opaque_tid() { int t = threadIdx.x; asm volatile("" : "+v"(t)); return t; }
namespace pg8 {
#define PG8_LAS __attribute__((address_space(3)))
typedef unsigned short bf16_t;
typedef short bf16x8 __attribute__((ext_vector_type(8)));
typedef float f32x4 __attribute__((ext_vector_type(4)));
typedef unsigned u32x4 __attribute__((ext_vector_type(4)));
constexpr int BM = 256, BK = 64, HALF = 128, HTB = HALF * BK * 2  , STAGE_BYTES = 8 * HTB, NXCD = 8, WGM = 8;

__host__ __device__ __forceinline__ int lds_byte(int r, int c) { const int st = (r >> 4) * 2 + (c >> 5), rr = r & 15, cc = c & 31, ob = rr * 64 + cc * 2; return st * 1024 + (ob ^ (((ob >> 9) & 1) << 5)); }
__host__ __device__ __forceinline__ void stage_rc(int b, int& R, int& C) { const int st = b / 1024, sb = b % 1024, swz = sb ^ (((sb >> 9) & 1) << 5); R = (st >> 1) * 16 + swz / 64; C = (st & 1) * 32 + (swz % 64) / 2; }
__host__ __device__ __forceinline__ int perm32(int rho) { const int n = rho >> 4, i = rho & 15; return 8 * (i >> 2) + 4 * n + (i & 3); }

struct Unit { int pm, pn, sel = 0, cont = 0; };
struct Gemm { const bf16_t* A; const bf16_t* Bt; int M, N, K; long dA1 = 0, dA2 = 0, dB1 = 0, dB2 = 0;
    __device__ __forceinline__ const char* a(int sel) const { return (const char*)A + (sel > 0 ? dA1 : 0l) + (sel > 1 ? dA2 : 0l); }
    __device__ __forceinline__ const char* b(int sel) const { return (const char*)Bt + (sel > 0 ? dB1 : 0l) + (sel > 1 ? dB2 : 0l); } };

struct StaticOrder {
    int nM, nN, nwg, G, c, chain = 0, prow = -1;
    __host__ __device__ void init(int M, int N, int G_, int c_) { nM = M / BM; nN = N / BM; nwg = nM * nN; G = G_; c = c_; prow = -1; chain = 0; }
    __host__ __device__ __forceinline__ void next_plain(int L, Unit& u) const {
        int wgid = L; { const int q = nwg / NXCD, r = nwg % NXCD, xcd = wgid % NXCD, off = wgid / NXCD; wgid = (xcd < r ? xcd * (q + 1) : r * (q + 1) + (xcd - r) * q) + off; }
        const int nig = WGM * nN, gid = wgid / nig, fm = gid * WGM, gsz = (nM - fm) < WGM ? (nM - fm) : WGM;
        u.pm = fm + ((wgid % nig) % gsz); u.pn = (wgid % nig) / gsz; u.sel = 0; u.cont = 0; }
    __host__ __device__ __forceinline__ bool next(int i, Unit& u) const {
        if (chain) { const int ti = i / 3; const long Lc = (long)ti * G + c; if (Lc >= nwg) return false; next_plain((int)Lc, u); u.sel = i - 3 * ti; u.cont = u.sel > 0; return true; }
        if (prow >= 0) { if (i > 0) return false; const int off = c >> 3; u.pm = prow * 32 + (c & 7) * 4 + (off >> 3); u.pn = off & 7; return true; }
        const long L = (long)i * G + c; if (L >= nwg) return false;
        int wgid = (int)L; { const int q = nwg / NXCD, r = nwg % NXCD, xcd = wgid % NXCD, off = wgid / NXCD; wgid = (xcd < r ? xcd * (q + 1) : r * (q + 1) + (xcd - r) * q) + off; }
        const int nig = WGM * nN, gid = wgid / nig, fm = gid * WGM, gsz = (nM - fm) < WGM ? (nM - fm) : WGM;
        u.pm = fm + ((wgid % nig) % gsz); u.pn = (wgid % nig) / gsz; return true;
    }
    __device__ __forceinline__ void a_ready(const Unit&) const {}
    __device__ __forceinline__ void done(const Unit&) const {}
};

__device__ __forceinline__ unsigned cvt_pk_bf16(float lo, float hi) { unsigned r; asm volatile("v_cvt_pk_bf16_f32 %0, %1, %2" : "=v"(r) : "v"(lo), "v"(hi)); return r; }
template <class Epi, class Sched, bool ALIGN_EPI = false, bool SP2 = false>
__device__ __forceinline__ void gemm_phase(PG8_LAS unsigned char* lds, const Gemm g, const Sched& S, const Epi& E) {
    const int tid = opaque_tid(), wid = __builtin_amdgcn_readfirstlane(tid >> 6), lane = tid & 63, wr = wid >> 2, wc = wid & 3, fr = lane & 15, fq = lane >> 4;
    const int K = g.K, nt = K / BK;
    unsigned voffA[2], voffB[2];
#pragma unroll
    for (int i = 0; i < 2; ++i) { int R, C; stage_rc(tid * 16 + i * 8192, R, C); const int Rb = Epi::PERM ? ((R & ~31) + perm32(R & 31)) : R;
        voffA[i] = (unsigned)(R * K + C) * 2u; voffB[i] = (unsigned)(Rb * K + C) * 2u; }
    const size_t kstep = (size_t)(BK * 2);
    const size_t hstep = (size_t)HALF * K * 2;
    const size_t tstep = 2 * hstep;
    const unsigned ldsw = (unsigned)wid * 1024u;
    const int aoff = lds_byte(wr * 64 + fr, fq * 8), boff = lds_byte(wc * 32 + fr, fq * 8);
#define PG8_SA(b, h) (((b) * 2 + (h)) * HTB)
#define PG8_SB(b, h) ((4 + (b) * 2 + (h)) * HTB)
#define PG8_STAGE(bufoff, gbase, voff) do { _Pragma("unroll") for (int _i = 0; _i < 2; ++_i) \
        __builtin_amdgcn_global_load_lds((const unsigned*)((const char*)(gbase) + (voff)[_i]), (PG8_LAS unsigned*)(lds + (bufoff) + ldsw + _i * 8192), 16, 0, 0); } while (0)
#define PG8_LDA(dst, b, h) do { _Pragma("unroll") for (int m = 0; m < 4; ++m) _Pragma("unroll") for (int k = 0; k < 2; ++k) dst[m][k] = *(const PG8_LAS bf16x8*)(lds + PG8_SA(b, h) + aoff + m * 2048 + k * 1024); } while (0)
#define PG8_LDB(dst, b, h) do { _Pragma("unroll") for (int n = 0; n < 2; ++n) _Pragma("unroll") for (int k = 0; k < 2; ++k) dst[n][k] = *(const PG8_LAS bf16x8*)(lds + PG8_SB(b, h) + boff + n * 2048 + k * 1024); } while (0)
#define PG8_MMA(ai, bj, At, Bt) do { __builtin_amdgcn_s_setprio(1); _Pragma("unroll") for (int m = 0; m < 4; ++m) _Pragma("unroll") for (int n = 0; n < 2; ++n) _Pragma("unroll") for (int k = 0; k < 2; ++k) \
        acc[ai][bj][m][n] = __builtin_amdgcn_mfma_f32_16x16x32_bf16(Bt[n][k], At[m][k], acc[ai][bj][m][n], 0, 0, 0); __builtin_amdgcn_s_setprio(0); } while (0)
#define PG8_WAIT_V(n) asm volatile("s_waitcnt vmcnt(" #n ")" ::: "memory")
#define PG8_WAIT_L(n) asm volatile("s_waitcnt lgkmcnt(" #n ")" ::: "memory")
#define PG8_BAR __builtin_amdgcn_s_barrier()
#define PG8_SCHED __builtin_amdgcn_sched_barrier(0)
    Unit cur, nxt; int ui = 0;
    if (!S.next(0, cur)) return;
    f32x4 acc[2][2][4][2];
#pragma unroll
    for (int a = 0; a < 2; ++a)
#pragma unroll
        for (int b = 0; b < 2; ++b)
#pragma unroll
            for (int m = 0; m < 4; ++m)
#pragma unroll
                for (int n = 0; n < 2; ++n) acc[a][b][m][n] = (f32x4){0.f, 0.f, 0.f, 0.f};
    bf16x8 At[4][2], B0[2][2], B1[2][2];
    const char* cA = g.a(cur.sel) + (size_t)cur.pm * tstep; const char* cB = g.b(cur.sel) + (size_t)cur.pn * tstep;
    S.a_ready(cur);
    if constexpr (SP2) {
        PG8_STAGE(PG8_SB(0, 0), cB, voffB); PG8_STAGE(PG8_SB(0, 1), cB + hstep, voffB); PG8_STAGE(PG8_SA(0, 0), cA, voffA); PG8_STAGE(PG8_SA(0, 1), cA + hstep, voffA);
        if (wr == 1) PG8_BAR;
        PG8_WAIT_V(2); PG8_BAR;
        PG8_STAGE(PG8_SB(1, 0), cB + kstep, voffB); PG8_STAGE(PG8_SA(1, 0), cA + kstep, voffA); PG8_STAGE(PG8_SB(1, 1), cB + hstep + kstep, voffB);
        PG8_WAIT_V(6); PG8_BAR;
    } else {
        PG8_STAGE(PG8_SB(0, 0), cB, voffB); PG8_STAGE(PG8_SA(0, 0), cA, voffA); PG8_STAGE(PG8_SB(0, 1), cB + hstep, voffB); PG8_STAGE(PG8_SA(0, 1), cA + hstep, voffA);
        if (wr == 1) PG8_BAR;
        PG8_WAIT_V(4); PG8_BAR;
        PG8_STAGE(PG8_SB(1, 0), cB + kstep, voffB); PG8_STAGE(PG8_SA(1, 0), cA + kstep, voffA); PG8_STAGE(PG8_SB(1, 1), cB + hstep + kstep, voffB);
        PG8_WAIT_V(6); PG8_BAR;
    }
    for (;;) {
        const bool has_next = S.next(ui + 1, nxt);
        const char* nA = has_next ? g.a(nxt.sel) + (size_t)nxt.pm * tstep : cA; const char* nB = has_next ? g.b(nxt.sel) + (size_t)nxt.pn * tstep : cB;
        for (int t = 0; t < nt; t += 2) {
            const bool last = (t == nt - 2);
            const char* a1 = cA + (size_t)(t + 1) * kstep;
            const char* a2 = last ? nA : cA + (size_t)(t + 2) * kstep; const char* b2 = last ? nB : cB + (size_t)(t + 2) * kstep;
            const char* a3 = a2 + kstep; const char* b3 = b2 + kstep;
            if (last && has_next) S.a_ready(nxt);
            if constexpr (SP2) {
            PG8_LDB(B0, 0, 0); PG8_LDB(B1, 0, 1); PG8_SCHED; PG8_LDA(At, 0, 0); PG8_STAGE(PG8_SA(1, 1), a1 + hstep, voffA);
            PG8_WAIT_V(8); PG8_WAIT_L(0); PG8_BAR; PG8_MMA(0, 0, At, B0); PG8_MMA(0, 1, At, B1); PG8_BAR; PG8_SCHED;
            PG8_LDA(At, 0, 1); PG8_STAGE(PG8_SB(0, 0), b2, voffB); PG8_STAGE(PG8_SB(0, 1), b2 + hstep, voffB); PG8_STAGE(PG8_SA(0, 0), a2, voffA);
            PG8_WAIT_V(8); PG8_WAIT_L(0); PG8_BAR; PG8_MMA(1, 0, At, B0); PG8_MMA(1, 1, At, B1); PG8_BAR; PG8_SCHED;
            PG8_LDB(B0, 1, 0); PG8_LDB(B1, 1, 1); PG8_SCHED; PG8_LDA(At, 1, 0); PG8_STAGE(PG8_SA(0, 1), a2 + hstep, voffA);
            PG8_WAIT_V(8); PG8_WAIT_L(0); PG8_BAR; PG8_MMA(0, 0, At, B0); PG8_MMA(0, 1, At, B1); PG8_BAR; PG8_SCHED;
            PG8_LDA(At, 1, 1); PG8_STAGE(PG8_SB(1, 0), b3, voffB); PG8_STAGE(PG8_SB(1, 1), b3 + hstep, voffB); PG8_STAGE(PG8_SA(1, 0), a3, voffA);
            PG8_WAIT_V(8); PG8_WAIT_L(0); PG8_BAR; PG8_MMA(1, 0, At, B0); PG8_MMA(1, 1, At, B1); PG8_BAR; PG8_SCHED;
            } else {
            PG8_LDB(B0, 0, 0); PG8_SCHED; PG8_LDA(At, 0, 0); PG8_STAGE(PG8_SA(1, 1), a1 + hstep, voffA);
            PG8_WAIT_L(8); PG8_BAR; PG8_WAIT_L(0); PG8_MMA(0, 0, At, B0); PG8_BAR; PG8_SCHED;
            PG8_LDB(B1, 0, 1); PG8_STAGE(PG8_SB(0, 0), b2, voffB);
            PG8_BAR; PG8_WAIT_L(0); PG8_MMA(0, 1, At, B1); PG8_BAR;
            PG8_LDA(At, 0, 1); PG8_STAGE(PG8_SA(0, 0), a2, voffA);
            PG8_BAR; PG8_WAIT_L(0); PG8_MMA(1, 0, At, B0); PG8_BAR; PG8_SCHED;
            PG8_STAGE(PG8_SB(0, 1), b2 + hstep, voffB);
            PG8_WAIT_V(6); PG8_BAR; PG8_MMA(1, 1, At, B1); PG8_BAR;
            PG8_LDB(B0, 1, 0); PG8_SCHED; PG8_LDA(At, 1, 0); PG8_STAGE(PG8_SA(0, 1), a2 + hstep, voffA);
            PG8_WAIT_L(8); PG8_BAR; PG8_WAIT_L(0); PG8_MMA(0, 0, At, B0); PG8_BAR; PG8_SCHED;
            PG8_LDB(B1, 1, 1); PG8_STAGE(PG8_SB(1, 0), b3, voffB);
            PG8_BAR; PG8_WAIT_L(0); PG8_MMA(0, 1, At, B1); PG8_BAR;
            PG8_LDA(At, 1, 1); PG8_STAGE(PG8_SA(1, 0), a3, voffA);
            PG8_BAR; PG8_WAIT_L(0); PG8_MMA(1, 0, At, B0); PG8_BAR; PG8_SCHED;
            PG8_STAGE(PG8_SB(1, 1), b3 + hstep, voffB);
            PG8_WAIT_V(6); PG8_BAR; PG8_MMA(1, 1, At, B1); PG8_BAR;
            }
        }
        if constexpr (ALIGN_EPI) { if (wr == 0) PG8_BAR; }
        if constexpr (!Epi::AFTER_DRAIN) { E(acc, cur, wr, wc, fr, fq); S.done(cur); }
        if (!has_next) break;
        if (!nxt.cont) {
#pragma unroll
        for (int a = 0; a < 2; ++a)
#pragma unroll
            for (int b = 0; b < 2; ++b)
#pragma unroll
                for (int m = 0; m < 4; ++m)
#pragma unroll
                    for (int n = 0; n < 2; ++n) acc[a][b][m][n] = (f32x4){0.f, 0.f, 0.f, 0.f};
        }
        cur = nxt; cA = nA; cB = nB; ++ui;
        if constexpr (ALIGN_EPI) { if (wr == 1) PG8_BAR; }
    }
    PG8_WAIT_V(0);
    if constexpr (!ALIGN_EPI) { if (wr == 0) PG8_BAR; }
    PG8_BAR;
    if constexpr (Epi::AFTER_DRAIN) { E.fused(acc, cur, wr, wc, fr, fq, lds, wid, lane); S.done(cur); }
#undef PG8_SA
#undef PG8_SB
#undef PG8_STAGE
#undef PG8_LDA
#undef PG8_LDB
#undef PG8_MMA
#undef PG8_WAIT_V
#undef PG8_WAIT_L
#undef PG8_BAR
#undef PG8_SCHED
}
}

#define LAS __attribute__((address_space(3)))
typedef unsigned short bf16_t;
typedef short bf16x8 __attribute__((ext_vector_type(8)));
typedef short s16x4 __attribute__((ext_vector_type(4)));
typedef float f32x4 __attribute__((ext_vector_type(4)));
typedef unsigned u32x4 __attribute__((ext_vector_type(4)));
typedef unsigned u32x2 __attribute__((ext_vector_type(2)));

constexpr int NWAVES = 8, NTHR = 512;
constexpr int DM = 2048, NB = 8, SEQ = 2048, MTOK = NB * SEQ;
constexpr int IN_DIM = 15432, IN_PAD = 15616;
constexpr int NMEM = 256;
constexpr float EPS = 1e-6f;
constexpr size_t MiB = 1u << 20;

constexpr size_t WS_CTL = 0;
constexpr size_t WS_CS = 1 * MiB;
constexpr size_t WS_WQT = 5 * MiB;
constexpr size_t WS_WKVT = 6 * MiB + 512 * 1024;
constexpr size_t WS_MKK = 9 * MiB;
constexpr size_t WS_MKV = 13 * MiB;
constexpr size_t WS_MZ = 17 * MiB;
constexpr size_t WS_ACQ = 49 * MiB;
constexpr size_t WS_ACKV = 65 * MiB;
constexpr size_t WS_WBRT = 49 * MiB;
constexpr size_t WS_WOUTT = 61 * MiB;
constexpr size_t WS_AZ = 81 * MiB;
constexpr size_t WS_CQ = 113 * MiB;
constexpr size_t WS_CZ = 145 * MiB;
constexpr size_t WS_GATES = 177 * MiB;
constexpr size_t WS_WMKVT = 177 * MiB;
constexpr size_t WS_MEMN = 185 * MiB;
constexpr size_t WS_MISC = 369 * MiB;
constexpr size_t WS_HBF = 377 * MiB;
constexpr size_t WS_WINT = 441 * MiB;
constexpr size_t WS_QN = 377 * MiB;
constexpr size_t WS_QR = 409 * MiB;
constexpr size_t WS_KN = 425 * MiB;
constexpr size_t WS_VA = 457 * MiB;
constexpr size_t WS_MERGED = 425 * MiB;
constexpr size_t WS_SSQ = 503 * MiB;
constexpr size_t WS_HALO = 504 * MiB;
constexpr size_t WS_NEED = 512 * MiB;
constexpr size_t DO_QK = 0, DO_MV = 64 * MiB, DO_MO = 96 * MiB;
constexpr int CW_QUEUE = 0;
constexpr int CW_MKVDONE = 64;
constexpr int CW_PANEL = 8192;
constexpr size_t WS_XS = 256 * 1024;
constexpr int CW_BAR = 4096;
constexpr size_t CTL_ZERO_BYTES = 65536;

constexpr int LDS_BYTES = 163840;

struct Args {
    const float* x; const float* mem; const int* pos; const float* w_in; const float* b_ig; const float* b_fg; const float* conv_w; const float* conv_b;
    const float* mh_norm; const float* cq_norm; const float* w_uq; const float* ckv_norm; const float* w_ukv; const float* mem_norm; const float* w_mem_kv;
    const float* w_br_m; const float* w_br_a; const float* w_br_c; const float* w_out; const float* norm; const float* final_norm;
    float* out; unsigned char* ws;
};

__device__ __forceinline__ unsigned f2bf(float f) { unsigned u = __builtin_bit_cast(unsigned, f); return (u + 0x7fffu + ((u >> 16) & 1u)) >> 16; }
typedef float f32x2_t __attribute__((ext_vector_type(2))); typedef __bf16 bf16x2_t __attribute__((ext_vector_type(2)));
__device__ __forceinline__ unsigned pk2(float lo, float hi) { f32x2_t v = {lo, hi}; bf16x2_t b = __builtin_convertvector(v, bf16x2_t); return __builtin_bit_cast(unsigned, b); }
__device__ __forceinline__ float bflo(unsigned w) { return __builtin_bit_cast(float, w << 16); }
__device__ __forceinline__ float bfhi(unsigned w) { return __builtin_bit_cast(float, w & 0xffff0000u); }
__device__ __forceinline__ float bf2f(bf16_t h) { return __builtin_bit_cast(float, (unsigned)h << 16); }
__device__ __forceinline__ float wave_sum(float v) {
#pragma unroll
    for (int o = 1; o < 64; o <<= 1) v += __shfl_xor(v, o);
    return v;
}
__device__ __forceinline__ float sigmoidf_(float v) { return __builtin_amdgcn_rcpf(1.0f + __builtin_amdgcn_exp2f(-1.4426950408889634f * v)); }
__device__ __forceinline__ float siluf_(float v) { return v * __builtin_amdgcn_rcpf(1.0f + __builtin_amdgcn_exp2f(-1.4426950408889634f * v)); }
#define LDS_WAIT() asm volatile("s_waitcnt lgkmcnt(0)" ::: "memory")
#define MFMA16(a, b, c) __builtin_amdgcn_mfma_f32_16x16x32_bf16((a), (b), (c), 0, 0, 0)

enum { GM_MKV = 0, GM_INPROJ = 1, GM_Q = 2, GM_KV = 3, GM_BR = 4, GM_OUT = 5, GM_OUTF = 6, GM_BRC = 7 };
struct EpiUni {
    static constexpr bool PERM = true, AFTER_DRAIN = false;
    int mode, br, mkv_need; unsigned char* ws; unsigned char* dob; const float* x; float* out; const float* fg; LAS unsigned char* xl;
    __device__ __forceinline__ void operator()(const f32x4 (&acc)[2][2][4][2], const pg8::Unit& u, int wr, int wc, int fr, int fq) const {
        const int row0 = u.pm * 256 + wr * 64 + fr;
        const int cl0 = wc * 32 + 8 * fq;
        if (mode <= GM_KV) {
            bf16_t* base; int ld, col0; float* ssq = nullptr; const float* rs = nullptr; int rope = 0; bool halo = false;
            const int pn = u.pn;
            if (mode == GM_INPROJ) {
                if (pn < 8) { base = (bf16_t*)(dob + DO_QK); ld = 2048; col0 = pn * 256; halo = true; }
                else if (pn < 12) { base = (bf16_t*)(dob + DO_MV); ld = 1024; col0 = (pn - 8) * 256; }
                else if (pn < 16) { base = (bf16_t*)(dob + DO_MO); ld = 1024; col0 = (pn - 12) * 256; }
                else if (pn < 20) { base = (bf16_t*)(ws + WS_MZ); ld = 1024; col0 = (pn - 16) * 256; }
                else if (pn < 22) { base = (bf16_t*)(ws + WS_ACQ); ld = 512; col0 = (pn - 20) * 256; ssq = (float*)(ws + WS_SSQ) + (pn - 20) * 4 + wc; }
                else if (pn < 24) { base = (bf16_t*)(ws + WS_ACKV); ld = 512; col0 = (pn - 22) * 256; ssq = (float*)(ws + WS_SSQ) + MTOK * 8 + (pn - 22) * 4 + wc; }
                else if (pn < 28) { base = (bf16_t*)(ws + WS_AZ); ld = 1024; col0 = (pn - 24) * 256; }
                else if (pn < 32) { base = (bf16_t*)(ws + WS_CQ); ld = 1024; col0 = (pn - 28) * 256; }
                else if (pn < 36) { base = (bf16_t*)(ws + WS_CZ); ld = 1024; col0 = (pn - 32) * 256; }
                else if (pn < 60) { base = (bf16_t*)(ws + WS_GATES); ld = 6144; col0 = (pn - 36) * 256;
                    if (mkv_need) { unsigned spin = 0; while ((unsigned)__builtin_amdgcn_readfirstlane(__hip_atomic_load((unsigned*)(ws + WS_CTL) + CW_MKVDONE, __ATOMIC_RELAXED, __HIP_MEMORY_SCOPE_AGENT)) < (unsigned)mkv_need && ++spin < (1u << 22)) __builtin_amdgcn_s_sleep(4); } }
                else { base = (bf16_t*)(ws + WS_MISC); ld = 256; col0 = 0; rope = 1; }
            } else if (mode == GM_MKV) {
                if (pn < 4) { base = (bf16_t*)(ws + WS_MKK); ld = 1024; col0 = pn * 256; }
                else { base = (bf16_t*)(ws + WS_MKV); ld = 1024; col0 = (pn - 4) * 256; }
            } else if (mode == GM_Q) {
                rs = (const float*)(ws + WS_SSQ);
                if (pn < 4) { base = (bf16_t*)(ws + WS_QN); ld = 1024; col0 = pn * 256; }
                else { base = (bf16_t*)(ws + WS_QR); ld = 512; col0 = (pn - 4) * 256; rope = 2; }
            } else {
                rs = (const float*)(ws + WS_SSQ) + MTOK * 8;
                if (pn < 4) { base = (bf16_t*)(ws + WS_KN); ld = 1024; col0 = pn * 256; }
                else { base = (bf16_t*)(ws + WS_VA); ld = 1024; col0 = (pn - 4) * 256; }
            }
            const float* cs = (const float*)(ws + WS_CS);
            float rstdv[8];
            if (rs) {
                f32x4 pp[8][2];
#pragma unroll
                for (int g8 = 0; g8 < 8; ++g8) { const int row = row0 + (g8 >> 2) * 128 + (g8 & 3) * 16; pp[g8][0] = *(const f32x4*)(rs + (size_t)row * 8); pp[g8][1] = *(const f32x4*)(rs + (size_t)row * 8 + 4); }
#pragma unroll
                for (int g8 = 0; g8 < 8; ++g8) rstdv[g8] = 1.0f / sqrtf((((pp[g8][0][0] + pp[g8][0][1]) + (pp[g8][0][2] + pp[g8][0][3])) + ((pp[g8][1][0] + pp[g8][1][1]) + (pp[g8][1][2] + pp[g8][1][3]))) * (1.0f / 512.0f) + EPS);
            } else {
#pragma unroll
                for (int g8 = 0; g8 < 8; ++g8) rstdv[g8] = 1.0f;
            }
#pragma unroll
            for (int ai = 0; ai < 2; ++ai)
#pragma unroll
                for (int m = 0; m < 4; ++m) {
                    const int row = row0 + ai * 128 + m * 16;
                    const float rstd = rstdv[ai * 4 + m];
                    float sq = 0.f;
#pragma unroll
                    for (int bj = 0; bj < 2; ++bj) {
                        f32x4 v0 = acc[ai][bj][m][0] * rstd, v1 = acc[ai][bj][m][1] * rstd;
                        const int cl = cl0 + bj * 128;
                        sq += (v0[0] * v0[0] + v0[1] * v0[1]) + (v0[2] * v0[2] + v0[3] * v0[3]) + (v1[0] * v1[0] + v1[1] * v1[1]) + (v1[2] * v1[2] + v1[3] * v1[3]);
                        if (rope == 2 || (rope == 1 && cl < 64)) {
                            const int i0 = (cl & 63) >> 1;
                            const f32x4 c01 = *(const f32x4*)(cs + ((size_t)row * 32 + i0) * 2);
                            const f32x4 c23 = *(const f32x4*)(cs + ((size_t)row * 32 + i0 + 2) * 2);
                            f32x4 w0, w1;
                            w0[0] = v0[0] * c01[0] - v0[1] * c01[1]; w0[1] = v0[1] * c01[0] + v0[0] * c01[1];
                            w0[2] = v0[2] * c01[2] - v0[3] * c01[3]; w0[3] = v0[3] * c01[2] + v0[2] * c01[3];
                            w1[0] = v1[0] * c23[0] - v1[1] * c23[1]; w1[1] = v1[1] * c23[0] + v1[0] * c23[1];
                            w1[2] = v1[2] * c23[2] - v1[3] * c23[3]; w1[3] = v1[3] * c23[2] + v1[2] * c23[3];
                            v0 = w0; v1 = w1;
                        }
                        u32x4 w; w.x = pk2(v0[0], v0[1]); w.y = pk2(v0[2], v0[3]); w.z = pk2(v1[0], v1[1]); w.w = pk2(v1[2], v1[3]);
                        *(u32x4*)(base + (size_t)row * ld + col0 + cl) = w;
                        if (halo && (m & 1) && fr >= 13) *(u32x4*)((bf16_t*)(ws + WS_HALO) + ((size_t)(row >> 5) * 3 + (fr - 13)) * 2048 + col0 + cl) = w;
                    }
                    if (ssq) {
                        sq += __shfl_xor(sq, 16); sq += __shfl_xor(sq, 32);
                        if (fq == 0) ssq[(size_t)row * 8] = sq;
                    }
                    asm volatile("" ::: "memory");
                }
        } else if (mode == GM_BR) {
            const bf16_t* gates = (const bf16_t*)(ws + WS_GATES) + (size_t)br * 2048 + u.pn * 256 + cl0; bf16_t* mg = (bf16_t*)(ws + WS_MERGED) + u.pn * 256 + cl0;
#pragma unroll
            for (int hb = 0; hb < 2; ++hb) {
                u32x4 gq[4][2], oq[4][2];
#pragma unroll
                for (int gg = 0; gg < 4; ++gg) { const int row_ = row0 + hb * 128 + gg * 16;
                    gq[gg][0] = *(const u32x4*)(gates + (size_t)row_ * 6144); gq[gg][1] = *(const u32x4*)(gates + (size_t)row_ * 6144 + 128);
                    if (br > 0) { oq[gg][0] = *(const u32x4*)(mg + (size_t)row_ * 2048); oq[gg][1] = *(const u32x4*)(mg + (size_t)row_ * 2048 + 128); } }
#pragma unroll
                for (int gg = 0; gg < 4; ++gg) {
                    const int row = row0 + hb * 128 + gg * 16;
#pragma unroll
                    for (int bj = 0; bj < 2; ++bj) {
                        const u32x4 g = gq[gg][bj];
                        f32x4 v0 = acc[hb][bj][gg][0], v1 = acc[hb][bj][gg][1];
                        v0[0] *= sigmoidf_(bflo(g.x)); v0[1] *= sigmoidf_(bfhi(g.x)); v0[2] *= sigmoidf_(bflo(g.y)); v0[3] *= sigmoidf_(bfhi(g.y));
                        v1[0] *= sigmoidf_(bflo(g.z)); v1[1] *= sigmoidf_(bfhi(g.z)); v1[2] *= sigmoidf_(bflo(g.w)); v1[3] *= sigmoidf_(bfhi(g.w));
                        if (br > 0) {
                            const u32x4 o = oq[gg][bj];
                            v0[0] += bflo(o.x); v0[1] += bfhi(o.x); v0[2] += bflo(o.y); v0[3] += bfhi(o.y);
                            v1[0] += bflo(o.z); v1[1] += bfhi(o.z); v1[2] += bflo(o.w); v1[3] += bfhi(o.w);
                        }
                        u32x4 w; w.x = pk2(v0[0], v0[1]); w.y = pk2(v0[2], v0[3]); w.z = pk2(v1[0], v1[1]); w.w = pk2(v1[2], v1[3]);
                        *(u32x4*)(mg + (size_t)row * 2048 + bj * 128) = w;
                    }
                }
                asm volatile("" ::: "memory");
            }
        } else if (mode == GM_BRC) {
            f32x4 (&a)[2][2][4][2] = const_cast<f32x4 (&)[2][2][4][2]>(acc);
            const int sel = u.sel;
            const bf16_t* ga = (const bf16_t*)(ws + WS_GATES) + (size_t)sel * 2048 + u.pn * 256 + cl0; bf16_t* mg = (bf16_t*)(ws + WS_MERGED) + u.pn * 256 + cl0;
#pragma unroll
            for (int hq4 = 0; hq4 < 4; ++hq4) {
                const int hb = hq4 >> 1, g0 = (hq4 & 1) * 2;
                u32x4 gq[2][2], hq[2][2];
#pragma unroll
                for (int gi2 = 0; gi2 < 2; ++gi2) { const int gg = gi2; const size_t ro = (size_t)(row0 + hb * 128 + (g0 + gi2) * 16) * 6144;
                    gq[gg][0] = *(const u32x4*)(ga + ro); gq[gg][1] = *(const u32x4*)(ga + ro + 128);
                    if (sel < 2) { hq[gg][0] = *(const u32x4*)(ga + ro + 2048); hq[gg][1] = *(const u32x4*)(ga + ro + 2048 + 128); } }
#pragma unroll
                for (int gi2 = 0; gi2 < 2; ++gi2) {
                    const int gg = gi2, gm = g0 + gi2; const int row = row0 + hb * 128 + gm * 16;
#pragma unroll
                    for (int bj = 0; bj < 2; ++bj) {
                        const u32x4 g = gq[gg][bj];
                        float f[8] = {sigmoidf_(bflo(g.x)), sigmoidf_(bfhi(g.x)), sigmoidf_(bflo(g.y)), sigmoidf_(bfhi(g.y)), sigmoidf_(bflo(g.z)), sigmoidf_(bfhi(g.z)), sigmoidf_(bflo(g.w)), sigmoidf_(bfhi(g.w))};
                        if (sel < 2) {
                            const u32x4 hn = hq[gg][bj];
                            const float t[8] = {bflo(hn.x), bfhi(hn.x), bflo(hn.y), bfhi(hn.y), bflo(hn.z), bfhi(hn.z), bflo(hn.w), bfhi(hn.w)};
#pragma unroll
                            for (int e = 0; e < 8; ++e) f[e] *= 1.0f + __builtin_amdgcn_exp2f(-1.4426950408889634f * t[e]);
                        }
                        f32x4 v0 = a[hb][bj][gm][0], v1 = a[hb][bj][gm][1];
                        v0[0] *= f[0]; v0[1] *= f[1]; v0[2] *= f[2]; v0[3] *= f[3]; v1[0] *= f[4]; v1[1] *= f[5]; v1[2] *= f[6]; v1[3] *= f[7];
                        if (sel == 2) {
                            u32x4 w; w.x = pk2(v0[0], v0[1]); w.y = pk2(v0[2], v0[3]); w.z = pk2(v1[0], v1[1]); w.w = pk2(v1[2], v1[3]);
                            *(u32x4*)(mg + (size_t)row * 2048 + bj * 128) = w;
                        } else { a[hb][bj][gm][0] = v0; a[hb][bj][gm][1] = v1; }
                    }
                }
                asm volatile("" ::: "memory");
            }
        } else if (mode == GM_OUTF) {
            f32x4 (&a)[2][2][4][2] = const_cast<f32x4 (&)[2][2][4][2]>(acc);
            LAS float* P = (LAS float*)xl;
            LAS float* R = (LAS float*)(xl + 4096);
            const int tid_ = (wr * 4 + wc) * 64 + fq * 16 + fr;
            const float* xb = x + u.pn * 256 + cl0;
#pragma unroll
            for (int hb = 0; hb < 2; ++hb) {
                f32x4 xq[4][4];
#pragma unroll
                for (int gg = 0; gg < 4; ++gg) { const size_t ro = (size_t)(row0 + hb * 128 + gg * 16) * 2048;
                    xq[gg][0] = *(const f32x4*)(xb + ro); xq[gg][1] = *(const f32x4*)(xb + ro + 4); xq[gg][2] = *(const f32x4*)(xb + ro + 128); xq[gg][3] = *(const f32x4*)(xb + ro + 132); }
#pragma unroll
                for (int gg = 0; gg < 4; ++gg) {
                    const int ai = hb, m = gg;
                    float sq = 0.f;
#pragma unroll
                    for (int bj = 0; bj < 2; ++bj) {
                        const f32x4 v0 = xq[gg][bj * 2] + a[ai][bj][m][0], v1 = xq[gg][bj * 2 + 1] + a[ai][bj][m][1];
                        a[ai][bj][m][0] = v0; a[ai][bj][m][1] = v1;
                        sq += (v0[0] * v0[0] + v0[1] * v0[1]) + (v0[2] * v0[2] + v0[3] * v0[3]) + (v1[0] * v1[0] + v1[1] * v1[1]) + (v1[2] * v1[2] + v1[3] * v1[3]);
                    }
                    sq += __shfl_xor(sq, 16); sq += __shfl_xor(sq, 32);
                    if (fq == 0) P[(wr * 64 + ai * 128 + m * 16 + fr) * 4 + wc] = sq;
                }
                asm volatile("" ::: "memory");
            }
            asm volatile("s_waitcnt lgkmcnt(0)" ::: "memory"); __builtin_amdgcn_s_barrier(); asm volatile("" ::: "memory");
            float* xs = (float*)(ws + WS_XS); unsigned* cnt = (unsigned*)(ws + WS_CTL) + CW_PANEL + 64 * u.pm;
            if (tid_ < 256) {
                const f32x4 p4 = *(const LAS f32x4*)(P + tid_ * 4);
                __hip_atomic_store(xs + ((size_t)(u.pm * 8 + u.pn) * 256 + tid_), (p4[0] + p4[1]) + (p4[2] + p4[3]), __ATOMIC_RELAXED, __HIP_MEMORY_SCOPE_AGENT);
            }
            asm volatile("s_waitcnt vmcnt(0)" ::: "memory"); __builtin_amdgcn_s_barrier(); asm volatile("" ::: "memory");
            if (tid_ == 0) {
                __hip_atomic_fetch_add(cnt, 1u, __ATOMIC_RELAXED, __HIP_MEMORY_SCOPE_AGENT);
                unsigned spin = 0;
                while (__hip_atomic_load(cnt, __ATOMIC_RELAXED, __HIP_MEMORY_SCOPE_AGENT) < 8u && ++spin < (1u << 24)) __builtin_amdgcn_s_sleep(2);
                __builtin_amdgcn_fence(__ATOMIC_ACQUIRE, "agent");
                asm volatile("s_waitcnt vmcnt(0)" ::: "memory");
            }
            __builtin_amdgcn_s_barrier(); asm volatile("" ::: "memory");
            if (tid_ < 256) {
                float t = 0.f;
#pragma unroll
                for (int j = 0; j < 8; ++j) t += __hip_atomic_load(xs + ((size_t)(u.pm * 8 + j) * 256 + tid_), __ATOMIC_RELAXED, __HIP_MEMORY_SCOPE_AGENT);
                R[tid_] = 1.0f / sqrtf(t * (1.0f / 2048.0f) + EPS);
            }
            asm volatile("s_waitcnt lgkmcnt(0)" ::: "memory"); __builtin_amdgcn_s_barrier(); asm volatile("" ::: "memory");
            f32x4 g4[2][2];
#pragma unroll
            for (int bj = 0; bj < 2; ++bj) { g4[bj][0] = *(const f32x4*)(fg + u.pn * 256 + cl0 + bj * 128); g4[bj][1] = *(const f32x4*)(fg + u.pn * 256 + cl0 + bj * 128 + 4); }
#pragma unroll
            for (int ai = 0; ai < 2; ++ai)
#pragma unroll
                for (int m = 0; m < 4; ++m) {
                    const int rl = wr * 64 + ai * 128 + m * 16 + fr; const float rstd = R[rl];
#pragma unroll
                    for (int bj = 0; bj < 2; ++bj) {
                        const size_t off = (size_t)(u.pm * 256 + rl) * 2048 + u.pn * 256 + cl0 + bj * 128;
                        *(f32x4*)(out + off) = a[ai][bj][m][0] * rstd * g4[bj][0];
                        *(f32x4*)(out + off + 4) = a[ai][bj][m][1] * rstd * g4[bj][1];
                    }
                }
            asm volatile("s_waitcnt lgkmcnt(0)" ::: "memory"); __builtin_amdgcn_s_barrier(); asm volatile("" ::: "memory");
        } else {
#pragma unroll
            for (int ai = 0; ai < 2; ++ai)
#pragma unroll
                for (int m = 0; m < 4; ++m) {
                    const int row = row0 + ai * 128 + m * 16;
#pragma unroll
                    for (int bj = 0; bj < 2; ++bj) {
                        const size_t off = (size_t)row * 2048 + u.pn * 256 + cl0 + bj * 128;
                        const f32x4 x0 = *(const f32x4*)(x + off), x1 = *(const f32x4*)(x + off + 4);
                        *(f32x4*)(out + off) = x0 + acc[ai][bj][m][0];
                        *(f32x4*)(out + off + 4) = x1 + acc[ai][bj][m][1];
                    }
                    asm volatile("" ::: "memory");
                }
        }
    }
};

enum { MAT_IN = 0, MAT_Q = 1, MAT_KV = 2, MAT_ID = 3 };
__device__ __forceinline__ int map_col(int mat, int n) {
    if (mat == MAT_IN) {
        if (n < 5120) return n;
        if (n < 6144) return 5128 + (n - 5120);
        if (n < 7168) return 6216 + (n - 6144);
        if (n < 8192) return 7240 + (n - 7168);
        if (n < 9216) return 8264 + (n - 8192);
        if (n < 15360) return 9288 + (n - 9216);
        const int j = n - 15360;
        if (j < 64) return 6152 + (j >> 1) + ((j & 1) ? 32 : 0);
        if (j < 68) return 5120 + (j - 64);
        if (j < 72) return 5124 + (j - 68);
        return -1;
    }
    if (mat == MAT_Q) {
        if (n < 1024) { const int h = n >> 7, d = n & 127; return h * 192 + d; }
        const int j = n - 1024, h = j >> 6, r = j & 63; return h * 192 + 128 + (r >> 1) + ((r & 1) ? 32 : 0);
    }
    if (mat == MAT_KV) {
        if (n < 1024) { const int h = n >> 7, d = n & 127; return h * 256 + d; }
        const int j = n - 1024, h = j >> 7, d = j & 127; return h * 256 + 128 + d;
    }
    return n;
}
__device__ __forceinline__ void transpose_item(const float* W, int K, int Nsrc, bf16_t* WT, int mat, const float* gain, LAS float* scr, int item, int nblk, int lane) {
    const int kb = item / nblk, nb = item % nblk, k0 = 64 * kb, n0 = 32 * nb;
    const int src = map_col(mat, n0 + (lane & 31));
    float v[32];
#pragma unroll
    for (int i = 0; i < 32; ++i) { const int kk = 2 * i + (lane >> 5); v[i] = (src >= 0) ? __builtin_nontemporal_load(W + (size_t)(k0 + kk) * Nsrc + src) : 0.f; }
#pragma unroll
    for (int i = 0; i < 32; ++i) { const int kk = 2 * i + (lane >> 5); float t = v[i]; if (gain) t *= gain[k0 + kk]; scr[kk * 33 + (lane & 31)] = t; }
    LDS_WAIT(); asm volatile("" ::: "memory");
    const int c = lane & 7;
#pragma unroll
    for (int j = 0; j < 4; ++j) {
        const int n = (lane >> 3) + 8 * j; const LAS float* s = scr + (8 * c) * 33 + n;
        u32x4 o; o.x = pk2(s[0 * 33], s[1 * 33]); o.y = pk2(s[2 * 33], s[3 * 33]); o.z = pk2(s[4 * 33], s[5 * 33]); o.w = pk2(s[6 * 33], s[7 * 33]);
        *(u32x4*)(WT + (size_t)(n0 + n) * K + k0 + 8 * c) = o;
    }
    LDS_WAIT(); asm volatile("" ::: "memory");
}
__device__ __forceinline__ void rms_row_to_bf16(const float* xrow, const float* gain, bf16_t* orow, int lane) {
    const f32x4* xr = (const f32x4*)xrow + lane;
    f32x4 v[8]; float s = 0.f;
#pragma unroll
    for (int j = 0; j < 8; ++j) { v[j] = __builtin_nontemporal_load(xr + 64 * j); s += (v[j][0] * v[j][0] + v[j][1] * v[j][1]) + (v[j][2] * v[j][2] + v[j][3] * v[j][3]); }
    const float rstd = 1.0f / sqrtf(wave_sum(s) * (1.0f / 2048.0f) + EPS);
    const f32x4* gr = (const f32x4*)gain + lane;
    u32x2* o8 = (u32x2*)orow + lane;
#pragma unroll
    for (int j = 0; j < 8; ++j) { const f32x4 g = gr[64 * j]; u32x2 w; w.x = pk2(v[j][0] * rstd * g[0], v[j][1] * rstd * g[1]); w.y = pk2(v[j][2] * rstd * g[2], v[j][3] * rstd * g[3]); o8[64 * j] = w; }
}

__device__ __forceinline__ void rms_row2_to_bf16(const float* xrow0, const float* xrow1, const float* gain, bf16_t* orow0, bf16_t* orow1, int lane) {
    const f32x4* xa = (const f32x4*)xrow0 + lane; const f32x4* xb = (const f32x4*)xrow1 + lane;
    f32x4 va[8], vb[8];
#pragma unroll
    for (int j = 0; j < 8; ++j) va[j] = __builtin_nontemporal_load(xa + 64 * j);
#pragma unroll
    for (int j = 0; j < 8; ++j) vb[j] = __builtin_nontemporal_load(xb + 64 * j);
    float sa = 0.f, sb = 0.f;
#pragma unroll
    for (int j = 0; j < 8; ++j) { sa += (va[j][0] * va[j][0] + va[j][1] * va[j][1]) + (va[j][2] * va[j][2] + va[j][3] * va[j][3]); sb += (vb[j][0] * vb[j][0] + vb[j][1] * vb[j][1]) + (vb[j][2] * vb[j][2] + vb[j][3] * vb[j][3]); }
#pragma unroll
    for (int o = 1; o < 64; o <<= 1) { sa += __shfl_xor(sa, o); sb += __shfl_xor(sb, o); }
    const float ra = 1.0f / sqrtf(sa * (1.0f / 2048.0f) + EPS), rb = 1.0f / sqrtf(sb * (1.0f / 2048.0f) + EPS);
    const f32x4* gr = (const f32x4*)gain + lane;
    u32x2* oa = (u32x2*)orow0 + lane; u32x2* ob = (u32x2*)orow1 + lane;
#pragma unroll
    for (int j = 0; j < 8; ++j) { const f32x4 g = gr[64 * j];
        u32x2 w; w.x = pk2(va[j][0] * ra * g[0], va[j][1] * ra * g[1]); w.y = pk2(va[j][2] * ra * g[2], va[j][3] * ra * g[3]); oa[64 * j] = w;
        u32x2 w2; w2.x = pk2(vb[j][0] * rb * g[0], vb[j][1] * rb * g[1]); w2.y = pk2(vb[j][2] * rb * g[2], vb[j][3] * rb * g[3]); ob[64 * j] = w2; }
}

template <int W1, int W2, int DV, bool CAUSAL, int NQ>
__device__ __forceinline__ void attn_unit(LAS unsigned char* lds,
        const bf16_t* Q1, int ldq1, const bf16_t* Q2, int ldq2,
        const bf16_t* K1, int ldk1, const bf16_t* K2, int ldk2,
        const bf16_t* V, int ldv, const bf16_t* Z, int ldz, bf16_t* O, int ldo,
        int nkt, int qb, float scale_log2) {
    constexpr int DQK = W1 + W2, NKS = DQK / 32, KSTR = DQK + 8, VROWB = DV * 2, NDT = DV / 16;
    constexpr int NK1 = W1 / 64, NV = DV / 64;
    constexpr int TILE_B = 64 * KSTR * 2 + 64 * VROWB;
    const int tid = opaque_tid(), lane = tid & 63, wid = tid >> 6, r16 = lane & 15, quad = lane >> 4;
    bf16x8 qf[NQ][NKS];
#pragma unroll
    for (int q = 0; q < NQ; ++q) {
        const bf16_t* q1 = Q1 + (size_t)(16 * NQ * wid + 16 * q + r16) * ldq1;
#pragma unroll
        for (int ks = 0; ks < W1 / 32; ++ks) qf[q][ks] = *(const bf16x8*)(q1 + 32 * ks + 8 * quad);
        if constexpr (W2 > 0) {
            const bf16_t* q2 = Q2 + (size_t)(16 * NQ * wid + 16 * q + r16) * ldq2;
#pragma unroll
            for (int ks = 0; ks < W2 / 32; ++ks) qf[q][W1 / 32 + ks] = *(const bf16x8*)(q2 + 32 * ks + 8 * quad);
        }
    }
    u32x4 pk1[NK1], pk2r, pv[NV];
    auto gload = [&](int kt) {
#pragma unroll
        for (int i = 0; i < NK1; ++i) { const int id = tid + 512 * i, row = id / (W1 / 8), cc = id % (W1 / 8); pk1[i] = *(const u32x4*)(K1 + (size_t)(64 * kt + row) * ldk1 + cc * 8); }
        if constexpr (W2 > 0) { const int row = tid >> 3, cc = tid & 7; pk2r = *(const u32x4*)(K2 + (size_t)(64 * kt + row) * ldk2 + cc * 8); }
#pragma unroll
        for (int i = 0; i < NV; ++i) { const int id = tid + 512 * i, row = id / (DV / 8), cc = id % (DV / 8); pv[i] = *(const u32x4*)(V + (size_t)(64 * kt + row) * ldv + cc * 8); }
    };
    auto lstore = [&](int bufi) {
        LAS bf16_t* Ks = (LAS bf16_t*)(lds + bufi * TILE_B); LAS unsigned char* Vi = lds + bufi * TILE_B + 64 * KSTR * 2;
#pragma unroll
        for (int i = 0; i < NK1; ++i) { const int id = tid + 512 * i, row = id / (W1 / 8), cc = id % (W1 / 8); *(LAS u32x4*)(Ks + row * KSTR + cc * 8) = pk1[i]; }
        if constexpr (W2 > 0) { const int row = tid >> 3, cc = tid & 7; *(LAS u32x4*)(Ks + row * KSTR + W1 + cc * 8) = pk2r; }
#pragma unroll
        for (int i = 0; i < NV; ++i) {
            const int id = tid + 512 * i, row = id / (DV / 8), cc = id % (DV / 8);
            *(LAS u32x4*)(Vi + VROWB * row + 16 * (cc ^ (((row & 3) << 2) | ((row >> 2) & 3)))) = pv[i];
        }
    };
    f32x4 o[NQ][NDT];
    float m_run[NQ], l_run[NQ];
#pragma unroll
    for (int q = 0; q < NQ; ++q) { m_run[q] = -1e30f; l_run[q] = 0.f;
#pragma unroll
        for (int d = 0; d < NDT; ++d) o[q][d] = (f32x4){0.f, 0.f, 0.f, 0.f}; }
    const int qpos0 = 128 * NQ * qb + 16 * NQ * wid + r16;
    __syncthreads();
    gload(0); lstore(0); if (nkt > 1) gload(1); __syncthreads();
    const int kdiag = CAUSAL ? (nkt - 2 * NQ) : nkt;
    for (int kt = 0; kt < nkt; ++kt) {
        const LAS bf16_t* Ks = (const LAS bf16_t*)(lds + (kt & 1) * TILE_B); const unsigned vbase = (unsigned)(size_t)(lds + (kt & 1) * TILE_B + 64 * KSTR * 2);
        if (kt + 1 < nkt) { lstore((kt + 1) & 1); if (kt + 2 < nkt) gload(kt + 2); }
        f32x4 s[NQ][4];
#pragma unroll
        for (int st = 0; st < 4; ++st) {
#pragma unroll
            for (int q = 0; q < NQ; ++q) s[q][st] = (f32x4){0.f, 0.f, 0.f, 0.f};
#pragma unroll
            for (int ks = 0; ks < NKS; ++ks) {
                const bf16x8 a = *(const LAS bf16x8*)(Ks + (16 * st + r16) * KSTR + 32 * ks + 8 * quad);
#pragma unroll
                for (int q = 0; q < NQ; ++q) s[q][st] = MFMA16(a, qf[q][ks], s[q][st]);
            }
        }
        bf16x8 pf[NQ][2];
#pragma unroll
        for (int q = 0; q < NQ; ++q) {
            if (CAUSAL && kt >= kdiag) {
#pragma unroll
                for (int st = 0; st < 4; ++st)
#pragma unroll
                    for (int j = 0; j < 4; ++j) { const int key = 64 * kt + 16 * st + 4 * quad + j; if (key > qpos0 + 16 * q) s[q][st][j] = -1e30f; }
            }
            float mx = fmaxf(fmaxf(fmaxf(s[q][0][0], s[q][0][1]), fmaxf(s[q][0][2], s[q][0][3])), fmaxf(fmaxf(s[q][1][0], s[q][1][1]), fmaxf(s[q][1][2], s[q][1][3])));
            mx = fmaxf(mx, fmaxf(fmaxf(fmaxf(s[q][2][0], s[q][2][1]), fmaxf(s[q][2][2], s[q][2][3])), fmaxf(fmaxf(s[q][3][0], s[q][3][1]), fmaxf(s[q][3][2], s[q][3][3]))));
            mx = fmaxf(mx, __shfl_xor(mx, 16)); mx = fmaxf(mx, __shfl_xor(mx, 32));
            const float m_new = (mx > m_run[q] + 5.0f / scale_log2) ? mx : m_run[q];
            const float nms = -m_new * scale_log2;
            float rs = 0.f;
#pragma unroll
            for (int st = 0; st < 4; ++st)
#pragma unroll
                for (int j = 0; j < 4; ++j) { const float p = __builtin_amdgcn_exp2f(__builtin_fmaf(s[q][st][j], scale_log2, nms)); s[q][st][j] = p; rs += p; }
            rs += __shfl_xor(rs, 16); rs += __shfl_xor(rs, 32);
            if (__builtin_amdgcn_ballot_w64(m_new != m_run[q]) != 0ull) {
                const float alpha = __builtin_amdgcn_exp2f((m_run[q] - m_new) * scale_log2);
                l_run[q] *= alpha;
#pragma unroll
                for (int d = 0; d < NDT; ++d) o[q][d] = o[q][d] * alpha;
            }
            l_run[q] += rs; m_run[q] = m_new;
#pragma unroll
            for (int kk = 0; kk < 2; ++kk) {
                u32x4 w; w.x = pk2(s[q][2 * kk][0], s[q][2 * kk][1]); w.y = pk2(s[q][2 * kk][2], s[q][2 * kk][3]); w.z = pk2(s[q][2 * kk + 1][0], s[q][2 * kk + 1][1]); w.w = pk2(s[q][2 * kk + 1][2], s[q][2 * kk + 1][3]);
                pf[q][kk] = __builtin_bit_cast(bf16x8, w);
            }
        }
        {
            const int g_ = quad, q_ = r16 >> 2, p_ = lane & 3;
            unsigned vlane = vbase + VROWB * (4 * g_ + q_) + 8 * (p_ & 1); asm volatile("" : "+v"(vlane));
            const int sw_ = (q_ << 2) | g_, ph_ = p_ >> 1;
            s16x4 vb[2][4];
#define TR_ISSUE(c_, bf_) do { const unsigned ad_ = vlane + 16u * (unsigned)((2 * (c_) + ph_) ^ sw_); \
                asm volatile("ds_read_b64_tr_b16 %0, %4\n\tds_read_b64_tr_b16 %1, %4 offset:%5\n\tds_read_b64_tr_b16 %2, %4 offset:%6\n\tds_read_b64_tr_b16 %3, %4 offset:%7" \
                    : "=&v"(vb[bf_][0]), "=&v"(vb[bf_][1]), "=&v"(vb[bf_][2]), "=&v"(vb[bf_][3]) : "v"(ad_), "n"(16 * VROWB), "n"(32 * VROWB), "n"(48 * VROWB) : "memory"); } while (0)
            TR_ISSUE(0, 0);
#pragma unroll
            for (int d = 0; d < NDT; ++d) {
                const int cur = d & 1;
                if (d + 1 < NDT) {
                    TR_ISSUE(d + 1, (d + 1) & 1);
                    asm volatile("s_waitcnt lgkmcnt(4)" : "+v"(vb[cur][0]), "+v"(vb[cur][1]), "+v"(vb[cur][2]), "+v"(vb[cur][3]) :: "memory");
                } else {
                    asm volatile("s_waitcnt lgkmcnt(0)" : "+v"(vb[cur][0]), "+v"(vb[cur][1]), "+v"(vb[cur][2]), "+v"(vb[cur][3]) :: "memory");
                }
                const bf16x8 a0 = __builtin_shufflevector(vb[cur][0], vb[cur][1], 0, 1, 2, 3, 4, 5, 6, 7);
                const bf16x8 a1 = __builtin_shufflevector(vb[cur][2], vb[cur][3], 0, 1, 2, 3, 4, 5, 6, 7);
#pragma unroll
                for (int q = 0; q < NQ; ++q) { o[q][d] = MFMA16(a0, pf[q][0], o[q][d]); o[q][d] = MFMA16(a1, pf[q][1], o[q][d]); }
            }
#undef TR_ISSUE
        }
        __syncthreads();
    }
#pragma unroll
    for (int q = 0; q < NQ; ++q) {
        const float linv = 1.0f / l_run[q];
        const bf16_t* zr = Z + (size_t)(16 * NQ * wid + 16 * q + r16) * ldz; bf16_t* orow = O + (size_t)(16 * NQ * wid + 16 * q + r16) * ldo;
#pragma unroll
        for (int d = 0; d < NDT; ++d) {
            const u32x2 z = *(const u32x2*)(zr + 16 * d + 4 * quad);
            u32x2 w; w.x = pk2(o[q][d][0] * linv * siluf_(bflo(z.x)), o[q][d][1] * linv * siluf_(bfhi(z.x))); w.y = pk2(o[q][d][2] * linv * siluf_(bflo(z.y)), o[q][d][3] * linv * siluf_(bfhi(z.y)));
            *(u32x2*)(orow + 16 * d + 4 * quad) = w;
        }
    }
}

__device__ __forceinline__ void conv_item(bf16_t* QK, const bf16_t* HALO, const float* conv_w, const float* conv_b, int hc, int cg) {
    const int chan = cg * 8; const float osc = (chan >= 1024) ? 0.0625f : 1.0f;
    float cw[4][8], cb[8];
#pragma unroll
    for (int j = 0; j < 4; ++j) { const f32x4 a = *(const f32x4*)(conv_w + j * 2048 + chan), c2 = *(const f32x4*)(conv_w + j * 2048 + chan + 4);
        cw[j][0] = a[0]; cw[j][1] = a[1]; cw[j][2] = a[2]; cw[j][3] = a[3]; cw[j][4] = c2[0]; cw[j][5] = c2[1]; cw[j][6] = c2[2]; cw[j][7] = c2[3]; }
    { const f32x4 a = *(const f32x4*)(conv_b + chan), c2 = *(const f32x4*)(conv_b + chan + 4); cb[0] = a[0]; cb[1] = a[1]; cb[2] = a[2]; cb[3] = a[3]; cb[4] = c2[0]; cb[5] = c2[1]; cb[6] = c2[2]; cb[7] = c2[3]; }
    float xp[3][8];
    if ((hc & 63) == 0) {
#pragma unroll
        for (int i = 0; i < 3; ++i)
#pragma unroll
            for (int ch = 0; ch < 8; ++ch) xp[i][ch] = 0.f;
    } else {
#pragma unroll
        for (int i = 0; i < 3; ++i) { const u32x4 xv = *(const u32x4*)(HALO + ((size_t)(hc - 1) * 3 + i) * 2048 + chan);
            xp[i][0] = bflo(xv.x); xp[i][1] = bfhi(xv.x); xp[i][2] = bflo(xv.y); xp[i][3] = bfhi(xv.y); xp[i][4] = bflo(xv.z); xp[i][5] = bfhi(xv.z); xp[i][6] = bflo(xv.w); xp[i][7] = bfhi(xv.w); }
    }
    bf16_t* base = QK + (size_t)hc * 32 * 2048 + chan;
    for (int sb = 0; sb < 4; ++sb) {
        u32x4 xr[8];
#pragma unroll
        for (int r = 0; r < 8; ++r) xr[r] = *(const u32x4*)(base + (size_t)(sb * 8 + r) * 2048);
#pragma unroll
        for (int r = 0; r < 8; ++r) {
            const u32x4 xv = xr[r];
            const float xf[8] = {bflo(xv.x), bfhi(xv.x), bflo(xv.y), bfhi(xv.y), bflo(xv.z), bfhi(xv.z), bflo(xv.w), bfhi(xv.w)};
            float y[8];
#pragma unroll
            for (int ch = 0; ch < 8; ++ch) {
                y[ch] = cb[ch] + cw[0][ch] * xp[0][ch] + cw[1][ch] * xp[1][ch] + cw[2][ch] * xp[2][ch] + cw[3][ch] * xf[ch];
                xp[0][ch] = xp[1][ch]; xp[1][ch] = xp[2][ch]; xp[2][ch] = xf[ch];
                y[ch] = siluf_(y[ch]) * osc;
            }
            u32x4 w; w.x = pk2(y[0], y[1]); w.y = pk2(y[2], y[3]); w.z = pk2(y[4], y[5]); w.w = pk2(y[6], y[7]);
            *(u32x4*)(base + (size_t)(sb * 8 + r) * 2048) = w;
        }
    }
}

constexpr int ML_QS = 0, ML_KS = 33792, ML_WKT = 67584, ML_VT0 = 104448, ML_VT1 = 109200, ML_CB0 = 113808, ML_CB1 = 131232, ML_SC = 148128;
__device__ __forceinline__ void mlstm_unit(LAS unsigned char* lds, int b, int h, int vp, const bf16_t* QK, const bf16_t* MV, bf16_t* HR, const bf16_t* MISC, float bi, float bfg) {
    LAS bf16_t* Qs = (LAS bf16_t*)(lds + ML_QS);
    LAS bf16_t* Ks = (LAS bf16_t*)(lds + ML_KS);
    LAS bf16_t* wKt = (LAS bf16_t*)(lds + ML_WKT);
    LAS bf16_t* Vt0 = (LAS bf16_t*)(lds + ML_VT0);
    LAS bf16_t* Vt1 = (LAS bf16_t*)(lds + ML_VT1);
    LAS bf16_t* Cb0 = (LAS bf16_t*)(lds + ML_CB0);
    LAS bf16_t* Cb1 = (LAS bf16_t*)(lds + ML_CB1);
    LAS float* scb = (LAS float*)(lds + ML_SC);
    const int tid = opaque_tid(), lane = tid & 63, wid = tid >> 6, r16 = lane & 15, quad = lane >> 4;
    __syncthreads();
    for (int i = tid; i < (ML_SC - ML_CB0) / 4; i += NTHR) ((LAS unsigned*)Cb0)[i] = 0u;
    if (tid < 72) Vt0[32 * 72 + tid] = (bf16_t)0x3F80;
    f32x4 cacc[2][3], cacc1[2][2];
#pragma unroll
    for (int a = 0; a < 2; ++a)
#pragma unroll
        for (int n = 0; n < 3; ++n) { cacc[a][n] = (f32x4){0.f, 0.f, 0.f, 0.f}; if (n < 2) cacc1[a][n] = (f32x4){0.f, 0.f, 0.f, 0.f}; }
    float m_state = 0.f;
    const int role = __builtin_amdgcn_readfirstlane(wid >> 2), cgl = lane & 31, rg = (wid & 3) * 2 + (lane >> 5);
    const int chan = role * 1024 + h * 256 + cgl * 8;
    const int tt = wid & 3, vh = wid >> 2;
    const size_t rowb = (size_t)b * SEQ;
    u32x4 xr[8], vreg; bf16_t graw_i = 0, graw_f = 0;
#define ML_LOAD(c_) do { const size_t r0_ = rowb + 64 * (c_); \
        _Pragma("unroll") for (int i = 0; i < 8; ++i) xr[i] = *(const u32x4*)(QK + (r0_ + rg * 8 + i) * 2048 + chan); \
        vreg = *(const u32x4*)(MV + (r0_ + (tid >> 3)) * 1024 + h * 256 + vp * 64 + (tid & 7) * 8); \
        if (wid == 0) { const bf16_t* mr = MISC + (r0_ + lane) * 256; graw_i = mr[64 + h]; graw_f = mr[68 + h]; } } while (0)
#define ML_GATES(s_) do { LAS float* sc_ = scb + 384 * (s_); \
        const float ic = bf2f(graw_i) + bi, fp = bf2f(graw_f) + bfg; \
        const float fc = fminf(fp, 0.f) - __logf(1.0f + __expf(-fabsf(fp))); \
        float bt = fc; \
        _Pragma("unroll") for (int o = 1; o < 64; o <<= 1) { const float t = __shfl_up(bt, o); if (lane >= o) bt += t; } \
        const float uu = ic - bt; float pm = uu; \
        _Pragma("unroll") for (int o = 1; o < 64; o <<= 1) { const float t = __shfl_up(pm, o); if (lane >= o) pm = fmaxf(pm, t); } \
        const float g = __shfl(bt, 63), pm63 = __shfl(pm, 63); \
        const float mx = fmaxf(m_state, pm), mx63 = fmaxf(m_state, pm63); \
        sc_[lane] = uu; sc_[64 + lane] = mx; sc_[128 + lane] = __expf(m_state - mx); sc_[192 + lane] = __expf(-(bt + mx)); sc_[256 + lane] = __expf(uu - mx63); \
        if (lane == 0) sc_[320] = __expf(m_state - mx63); \
        m_state = g + mx63; } while (0)
    ML_LOAD(0);
    if (wid == 0) ML_GATES(0);
    __syncthreads();
    for (int c = 0; c < 32; ++c) {
        LAS float* sc = scb + 384 * (c & 1);
        {
#pragma unroll
            for (int r = 0; r < 8; ++r) *(LAS u32x4*)((role == 0 ? Qs : Ks) + (rg * 8 + r) * 264 + cgl * 8) = xr[r];
            if (role == 1) {
#pragma unroll
                for (int rp = 0; rp < 4; ++rp) {
                    const int t0 = rg * 8 + 2 * rp;
                    const float w0 = sc[256 + t0], w1 = sc[256 + t0 + 1];
                    const u32x4 xa = xr[2 * rp], xb = xr[2 * rp + 1];
                    const float fa[8] = {bflo(xa.x), bfhi(xa.x), bflo(xa.y), bfhi(xa.y), bflo(xa.z), bfhi(xa.z), bflo(xa.w), bfhi(xa.w)};
                    const float fb[8] = {bflo(xb.x), bfhi(xb.x), bflo(xb.y), bfhi(xb.y), bflo(xb.z), bfhi(xb.z), bflo(xb.w), bfhi(xb.w)};
#pragma unroll
                    for (int ch = 0; ch < 8; ++ch) *(LAS unsigned*)(wKt + (cgl * 8 + ch) * 72 + (((t0 >> 3) ^ (cgl & 7)) << 3) + (t0 & 7)) = pk2(fa[ch] * w0, fb[ch] * w1);
                }
            }
            {
                const int s = tid >> 3, cc = tid & 3; LAS bf16_t* Vt = (tid & 4) ? Vt1 : Vt0;
                const unsigned w[4] = {vreg.x, vreg.y, vreg.z, vreg.w};
#pragma unroll
                for (int j = 0; j < 4; ++j) { const int sc2 = (((s >> 2) ^ (4 * cc)) << 2) + (s & 3); Vt[(cc * 8 + 2 * j) * 72 + sc2] = (bf16_t)(w[j] & 0xffffu); Vt[(cc * 8 + 2 * j + 1) * 72 + sc2] = (bf16_t)(w[j] >> 16); }
            }
        }
        __syncthreads();
        if (c + 1 < 32) ML_LOAD(c + 1);
        const float decay = sc[320];
        {
            const LAS bf16_t* qrow = Qs + (16 * tt + r16) * 264 + 8 * quad;
#define QF(ks_) (*(const LAS bf16x8*)(qrow + 32 * (ks_)))
            const int tpos = 16 * tt + r16;
            const float mxt = sc[64 + tpos];
            f32x4 p[4];
#pragma unroll
            for (int st = 0; st < 4; ++st) {
                p[st] = (f32x4){0.f, 0.f, 0.f, 0.f};
                if (st <= tt) {
#pragma unroll
                    for (int ks = 0; ks < 8; ++ks) { const bf16x8 a = *(const LAS bf16x8*)(Ks + (16 * st + r16) * 264 + 32 * ks + 8 * quad); p[st] = MFMA16(a, QF(ks), p[st]); }
                    const f32x4 uu = *(const LAS f32x4*)(sc + 16 * st + 4 * quad);
#pragma unroll
                    for (int j = 0; j < 4; ++j) { const int sp = 16 * st + 4 * quad + j; p[st][j] = (sp <= tpos) ? p[st][j] * __expf(uu[j] - mxt) : 0.f; }
                }
            }
            __builtin_amdgcn_sched_barrier(0);
            bf16x8 pf[2];
#pragma unroll
            for (int kk = 0; kk < 2; ++kk) {
                u32x4 w; w.x = pk2(p[2 * kk][0], p[2 * kk][1]); w.y = pk2(p[2 * kk][2], p[2 * kk][3]); w.z = pk2(p[2 * kk + 1][0], p[2 * kk + 1][1]); w.w = pk2(p[2 * kk + 1][2], p[2 * kk + 1][3]);
                pf[kk] = __builtin_bit_cast(bf16x8, w);
            }
            __builtin_amdgcn_sched_barrier(0);
            f32x4 ia = (f32x4){0.f, 0.f, 0.f, 0.f}, ib = ia, na = ia, nb = ia, ia1 = ia, na1 = ia;
#pragma unroll
            for (int ks = 0; ks < 8; ++ks) {
                const bf16x8 a0 = *(const LAS bf16x8*)(Cb0 + (16 * vh + r16) * 264 + 32 * ks + 8 * quad);
                const bf16x8 a1 = *(const LAS bf16x8*)(Cb0 + (32 + r16) * 264 + 32 * ks + 8 * quad);
                const bf16x8 a2 = *(const LAS bf16x8*)(Cb1 + (16 * vh + r16) * 264 + 32 * ks + 8 * quad);
                const bf16x8 qv = QF(ks); ia = MFMA16(a0, qv, ia); ib = MFMA16(a1, qv, ib); ia1 = MFMA16(a2, qv, ia1);
            }
#pragma unroll
            for (int kk = 0; kk < 2; ++kk) {
                const int vsw = 4 * (2 * vh + (r16 >> 3));
                const s16x4 lo0 = *(const LAS s16x4*)(Vt0 + (16 * vh + r16) * 72 + (((8 * kk + quad) ^ vsw) << 2)), hi0 = *(const LAS s16x4*)(Vt0 + (16 * vh + r16) * 72 + (((8 * kk + 4 + quad) ^ vsw) << 2));
                const s16x4 lo1 = *(const LAS s16x4*)(Vt0 + (32 + r16) * 72 + 32 * kk + 4 * quad), hi1 = *(const LAS s16x4*)(Vt0 + (32 + r16) * 72 + 32 * kk + 16 + 4 * quad);
                const s16x4 lo2 = *(const LAS s16x4*)(Vt1 + (16 * vh + r16) * 72 + (((8 * kk + quad) ^ vsw) << 2)), hi2 = *(const LAS s16x4*)(Vt1 + (16 * vh + r16) * 72 + (((8 * kk + 4 + quad) ^ vsw) << 2));
                na = MFMA16(__builtin_shufflevector(lo0, hi0, 0, 1, 2, 3, 4, 5, 6, 7), pf[kk], na);
                nb = MFMA16(__builtin_shufflevector(lo1, hi1, 0, 1, 2, 3, 4, 5, 6, 7), pf[kk], nb);
                na1 = MFMA16(__builtin_shufflevector(lo2, hi2, 0, 1, 2, 3, 4, 5, 6, 7), pf[kk], na1);
            }
            __builtin_amdgcn_sched_barrier(0);
            const float wi = sc[128 + tpos], en = sc[192 + tpos];
            const float denq = wi * ib[0] + nb[0];
            const float den = __shfl(denq, r16);
            const float dinv = 1.0f / fmaxf(fabsf(den), en);
            u32x2 w; w.x = pk2((wi * ia[0] + na[0]) * dinv, (wi * ia[1] + na[1]) * dinv); w.y = pk2((wi * ia[2] + na[2]) * dinv, (wi * ia[3] + na[3]) * dinv);
            *(u32x2*)(HR + ((size_t)(h * 8 + 2 * vp) * 2048 + 64 * c + tpos) * 32 + 16 * vh + 4 * quad) = w;
            w.x = pk2((wi * ia1[0] + na1[0]) * dinv, (wi * ia1[1] + na1[1]) * dinv); w.y = pk2((wi * ia1[2] + na1[2]) * dinv, (wi * ia1[3] + na1[3]) * dinv);
            *(u32x2*)(HR + ((size_t)(h * 8 + 2 * vp + 1) * 2048 + 64 * c + tpos) * 32 + 16 * vh + 4 * quad) = w;
        }
        asm volatile("s_waitcnt lgkmcnt(0)" ::: "memory"); __builtin_amdgcn_s_barrier(); asm volatile("" ::: "memory");
        {
#pragma unroll
            for (int a = 0; a < 2; ++a) {
                const int mt = 2 * wid + a;
                bf16x8 af[2];
#pragma unroll
                for (int kk = 0; kk < 2; ++kk) af[kk] = *(const LAS bf16x8*)(wKt + (16 * mt + r16) * 72 + (((4 * kk + quad) ^ ((2 * mt + (r16 >> 3)) & 7)) << 3));
#pragma unroll
                for (int n = 0; n < 3; ++n) {
                    f32x4 acc = cacc[a][n] * decay;
#pragma unroll
                    for (int kk = 0; kk < 2; ++kk) {
                        const bf16x8 bfr = *(const LAS bf16x8*)(Vt0 + (16 * n + r16) * 72 + ((((8 * kk + 2 * quad) ^ ((n < 2) ? 4 * ((2 * n + (r16 >> 3)) & 3) : 0))) << 2));
                        acc = MFMA16(af[kk], bfr, acc);
                    }
                    cacc[a][n] = acc;
                    u32x2 w; w.x = pk2(acc[0], acc[1]); w.y = pk2(acc[2], acc[3]);
                    if (n < 2 || r16 == 0) *(LAS u32x2*)(Cb0 + (16 * n + r16) * 264 + 16 * mt + 4 * quad) = w;
                }
#pragma unroll
                for (int n = 0; n < 2; ++n) {
                    f32x4 acc = cacc1[a][n] * decay;
#pragma unroll
                    for (int kk = 0; kk < 2; ++kk) {
                        const bf16x8 bfr = *(const LAS bf16x8*)(Vt1 + (16 * n + r16) * 72 + ((((8 * kk + 2 * quad) ^ (4 * ((2 * n + (r16 >> 3)) & 3)))) << 2));
                        acc = MFMA16(af[kk], bfr, acc);
                    }
                    cacc1[a][n] = acc;
                    u32x2 w; w.x = pk2(acc[0], acc[1]); w.y = pk2(acc[2], acc[3]);
                    *(LAS u32x2*)(Cb1 + (16 * n + r16) * 264 + 16 * mt + 4 * quad) = w;
                }
            }
            if (wid == 0 && c + 1 < 32) ML_GATES((c + 1) & 1);
        }
        __syncthreads();
    }
#undef QF
#undef ML_LOAD
#undef ML_GATES
}

__device__ __forceinline__ size_t hraw_off(int b) { return (b < 3) ? (489 * MiB + (size_t)b * 4 * MiB) : (b < 5 ? (504 * MiB + (size_t)(b - 3) * 4 * MiB) : (69 * MiB + (size_t)(b - 5) * 4 * MiB)); }
#define XB_TMO      128
#define XB_XCNT(j)  (256  + 64 * (j))
#define XB_XSUB(j)  (1280 + 64 * (j))
#define XB_XGEN(j)  (2304 + 64 * (j))
#define XB_TOP      3328
#define XB_TOPGEN   3392
#define XCD_BAR_WORDS 3456
#define XB_SPIN_CAP (1u << 18)

__device__ __forceinline__ unsigned xb_ld(unsigned* p)              { return __hip_atomic_load(p, __ATOMIC_RELAXED, __HIP_MEMORY_SCOPE_AGENT); }
__device__ __forceinline__ unsigned xb_add(unsigned* p, unsigned v) { return __hip_atomic_fetch_add(p, v, __ATOMIC_RELAXED, __HIP_MEMORY_SCOPE_AGENT); }
__device__ __forceinline__ unsigned xb_xcc_id() { return (unsigned)__builtin_amdgcn_s_getreg((3 << 11) | 20) & 0xFu; }
#define XB_SPIN(cond, bar) do { unsigned _sp = 0; while (cond) { __builtin_amdgcn_s_sleep(1); \
    if ((++_sp & 255u) == 0u) { if (xb_ld(&(bar)[XB_TMO])) break; if (_sp > XB_SPIN_CAP) { atomicAdd(&(bar)[XB_TMO], 1u); break; } } } } while (0)

struct XcdBarrier {
    unsigned* bar; unsigned x;
    volatile LAS unsigned* st;
};

__device__ __forceinline__ XcdBarrier xcd_barrier_post(unsigned* bar, volatile LAS unsigned* st) {
    XcdBarrier b; b.bar = bar; b.x = xb_xcc_id(); b.st = st;
    if (threadIdx.x == 0) (void)xb_add(&bar[XB_XCNT(b.x)], 1u);
    return b;
}
__device__ __forceinline__ void xcd_barrier_complete(unsigned* bar, unsigned x, unsigned& nloc, unsigned& nx) {
    const unsigned G = gridDim.x * gridDim.y * gridDim.z;
    unsigned sum, cnt, mine, sp = 0u;
    for (;;) {
        sum = 0u; cnt = 0u; mine = 0u;
#pragma unroll
        for (unsigned j = 0; j < 16; ++j) { const unsigned c = xb_ld(&bar[XB_XCNT(j)]); sum += c; cnt += (c > 0u) ? 1u : 0u; mine = (j == x) ? c : mine; }
        if (sum == G) break;
        __builtin_amdgcn_s_sleep(1);
        if ((++sp & 255u) == 0u) { if (xb_ld(&bar[XB_TMO])) break; if (sp > XB_SPIN_CAP) { atomicAdd(&bar[XB_TMO], 1u); break; } }
    }
    nloc = mine > 0u ? mine : 1u; nx = cnt > 0u ? cnt : 1u;
}

__device__ __forceinline__ void xcd_barrier(const XcdBarrier& b) {
    asm volatile("s_waitcnt vmcnt(0)" ::: "memory");
    __syncthreads();
    if (threadIdx.x == 0) {
        unsigned* bar = b.bar;
        __builtin_amdgcn_s_waitcnt(0);
        unsigned nloc = b.st[0], nx = b.st[1];
        if (nloc == 0u) { xcd_barrier_complete(bar, b.x, nloc, nx); b.st[0] = nloc; b.st[1] = nx; }
        const unsigned old = xb_add(&bar[XB_XSUB(b.x)], 1u);
        const unsigned gen = old / nloc;
        if (old + 1u == (gen + 1u) * nloc) {
            __builtin_amdgcn_fence(__ATOMIC_RELEASE, "agent");
            asm volatile("s_waitcnt vmcnt(0)" ::: "memory");
            const unsigned og = xb_add(&bar[XB_TOP], 1u);
            const unsigned tg = og / nx;
            if (og + 1u == (tg + 1u) * nx) xb_add(&bar[XB_TOPGEN], 1u);
            else XB_SPIN(xb_ld(&bar[XB_TOPGEN]) == tg, bar);
            __builtin_amdgcn_fence(__ATOMIC_ACQUIRE, "agent");
            xb_add(&bar[XB_XGEN(b.x)], 1u);
            asm volatile("s_waitcnt vmcnt(0)" ::: "memory");
        } else {
            XB_SPIN(xb_ld(&bar[XB_XGEN(b.x)]) == gen, bar);
            __builtin_amdgcn_fence(__ATOMIC_ACQUIRE, "agent");
            asm volatile("s_waitcnt vmcnt(0)" ::: "memory");
        }
    }
    __syncthreads();
}

__global__ void __launch_bounds__(NTHR, 2) fwd_megakernel(Args A) {
    extern __shared__ __attribute__((aligned(16))) unsigned char lds_raw[];
    LAS unsigned char* lds = (LAS unsigned char*)lds_raw;
    cg::grid_group grid = cg::this_grid();
#define GRID_SYNC() do { XcdBarrier b_ = xbar; asm volatile("" : "+s"(b_.bar)); xcd_barrier(b_); } while (0)
    const int wid = __builtin_amdgcn_readfirstlane(threadIdx.x >> 6);
    const int G = gridDim.x, bx = blockIdx.x;
    const int gw = bx * NWAVES + wid, NGW = G * NWAVES;
    unsigned char* ws = A.ws; unsigned char* dob = (unsigned char*)A.out;
    unsigned* ctl = (unsigned*)(ws + WS_CTL);
    LAS float* scr = (LAS float*)(lds + wid * 16384);
    for (int i = threadIdx.x; i < LDS_BYTES / 4; i += NTHR) ((LAS unsigned*)lds)[i] = 0u;
    __syncthreads();
    XcdBarrier xbar = xcd_barrier_post(ctl + CW_BAR, (volatile LAS unsigned*)(lds + LDS_BYTES - 64));
    grid.sync();

    {
        const int tid = opaque_tid(), lane = tid & 63;
        constexpr int I_IN = 32 * (IN_PAD / 32), I_Q = 8 * 48, I_KV = 8 * 64, I_MKV = 32 * 64;
        for (int it = gw; it < I_IN + I_Q + I_KV + I_MKV; it += NGW) {
            int r = it;
            if (r < I_IN) { transpose_item(A.w_in, 2048, IN_DIM, (bf16_t*)(ws + WS_WINT), MAT_IN, nullptr, scr, r, IN_PAD / 32, lane); continue; } r -= I_IN;
            if (r < I_Q) { transpose_item(A.w_uq, 512, 1536, (bf16_t*)(ws + WS_WQT), MAT_Q, A.cq_norm, scr, r, 48, lane); continue; } r -= I_Q;
            if (r < I_KV) { transpose_item(A.w_ukv, 512, 2048, (bf16_t*)(ws + WS_WKVT), MAT_KV, A.ckv_norm, scr, r, 64, lane); continue; } r -= I_KV;
            transpose_item(A.w_mem_kv, 2048, 2048, (bf16_t*)(ws + WS_WMKVT), MAT_ID, nullptr, scr, r, 64, lane);
        }
        for (int m = gw; m < NB * NMEM; m += NGW) rms_row_to_bf16(A.mem + (size_t)m * DM, A.mem_norm, (bf16_t*)(ws + WS_MEMN) + (size_t)m * DM, lane);
        for (int m = gw; m < MTOK; m += 2 * NGW) {
            if (m + NGW < MTOK) rms_row2_to_bf16(A.x + (size_t)m * DM, A.x + (size_t)(m + NGW) * DM, A.norm, (bf16_t*)(ws + WS_HBF) + (size_t)m * DM, (bf16_t*)(ws + WS_HBF) + (size_t)(m + NGW) * DM, lane);
            else rms_row_to_bf16(A.x + (size_t)m * DM, A.norm, (bf16_t*)(ws + WS_HBF) + (size_t)m * DM, lane);
        }
        float* cs = (float*)(ws + WS_CS);
        for (int i = bx * NTHR + tid; i < MTOK * 32; i += G * NTHR) {
            const int tok = i >> 5, fi = i & 31;
            const float invf = exp2f(-(float)fi * (13.287712379549449f / 32.0f));
            const float ang = (float)A.pos[tok] * invf;
            const double rev = (double)ang * 0.15915494309189535;
            const float fr = (float)(rev - rint(rev));
            cs[2 * i] = __builtin_amdgcn_cosf(fr); cs[2 * i + 1] = __builtin_amdgcn_sinf(fr);
        }
    }
    GRID_SYNC();
    const int gb = (G >= 128) ? 64 : G;
    for (int gi = 0; gi < 4; ++gi) {
        unsigned char* ws = A.ws; unsigned char* dob = (unsigned char*)A.out; asm volatile("" : "+s"(ws), "+s"(dob));
        pg8::Gemm g; pg8::StaticOrder S; EpiUni E; E.mode = 0; E.mkv_need = (G == 256) ? 64 : 0; E.ws = ws; E.dob = dob; E.x = A.x; E.out = A.out; E.br = 0; E.fg = A.final_norm; E.xl = lds + 131072;
        bool run = true;
        switch (gi) {
            case 0: g = pg8::Gemm{(const pg8::bf16_t*)(ws + WS_MEMN), (const pg8::bf16_t*)(ws + WS_WMKVT), NB * NMEM, 2048, 2048}; E.mode = GM_MKV;
                    if (G >= 128) { run = bx >= G - gb; S.init(g.M, g.N, gb, bx - (G - gb)); } else S.init(g.M, g.N, G, bx); break;
            case 1: g = pg8::Gemm{(const pg8::bf16_t*)(ws + WS_HBF), (const pg8::bf16_t*)(ws + WS_WINT), MTOK, IN_PAD, 2048}; E.mode = GM_INPROJ; S.init(g.M, g.N, G, bx); break;
            case 2: g = pg8::Gemm{(const pg8::bf16_t*)(ws + WS_ACQ), (const pg8::bf16_t*)(ws + WS_WQT), MTOK, 1536, 512}; E.mode = GM_Q; S.init(g.M, g.N, G, bx); break;
            case 3: g = pg8::Gemm{(const pg8::bf16_t*)(ws + WS_ACKV), (const pg8::bf16_t*)(ws + WS_WKVT), MTOK, 2048, 512}; E.mode = GM_KV; S.init(g.M, g.N, G, bx); break;
            case 4: case 5: case 6: {
                const int br = gi - 4;
                const unsigned char* ap = (br == 0) ? (dob + DO_MV) : (br == 1 ? ws + WS_QN : ws + WS_CQ);
                g = pg8::Gemm{(const pg8::bf16_t*)ap, (const pg8::bf16_t*)(ws + WS_WBRT + (size_t)br * 4 * MiB), MTOK, 2048, 1024}; E.mode = GM_BR; E.br = br; S.init(g.M, g.N, G, bx); break; }
            default: g = pg8::Gemm{(const pg8::bf16_t*)(ws + WS_MERGED), (const pg8::bf16_t*)(ws + WS_WOUTT), MTOK, 2048, 2048}; E.mode = GM_OUT; S.init(g.M, g.N, G, bx); break;
        }
        if (gi == 2) {
            const int t = opaque_tid();
            for (int it = bx; it < 256; it += G) conv_item((bf16_t*)(dob + DO_QK), (const bf16_t*)(ws + WS_HALO), A.conv_w, A.conv_b, it * 2 + (t >> 8), t & 255);
        }
#ifndef NO_GEMM
        if (run) pg8::gemm_phase<EpiUni, pg8::StaticOrder, true, true>(lds, g, S, E);
#endif
        if (gi == 0) {
            if (G == 256) {
                if (run) { asm volatile("s_waitcnt vmcnt(0)" ::: "memory"); __syncthreads(); if (opaque_tid() == 0) __hip_atomic_fetch_add((unsigned*)(ws + WS_CTL) + CW_MKVDONE, 1u, __ATOMIC_RELAXED, __HIP_MEMORY_SCOPE_AGENT); }
            } else GRID_SYNC();
        }
        if (gi == 1 || gi == 6) GRID_SYNC();
    }
    {
        unsigned char* ws = A.ws; unsigned char* dob = (unsigned char*)A.out; asm volatile("" : "+s"(ws), "+s"(dob)); unsigned* ctl = (unsigned*)(ws + WS_CTL);
            GRID_SYNC();
            constexpr int U_ML = 128, U_AT = 512, U_CA = 512, U_CV = 5 * 128;
            LAS int* qslot = (LAS int*)(lds + LDS_BYTES - 16);
            for (;;) {
                const int tid = opaque_tid();
                __syncthreads();
                if (tid == 0) *qslot = (int)atomicAdd(ctl + CW_QUEUE, 1u);
                __syncthreads();
                const int ui = *qslot;
                if (ui >= U_ML + U_AT + U_CA + U_CV) break;
                if (ui < U_ML) {
                    const int vp = ui & 3, h = (ui >> 2) & 3, b = ui >> 4;
#ifndef NO_ML
                    mlstm_unit(lds, b, h, vp, (const bf16_t*)(dob + DO_QK), (const bf16_t*)(dob + DO_MV), (bf16_t*)(ws + hraw_off(b)), (const bf16_t*)(ws + WS_MISC), A.b_ig[h], A.b_fg[h]);
#endif
                } else if (ui < U_ML + U_AT) {
                    const int r = ui - U_ML, qb = 7 - (r >> 6), bh = r & 63, b = bh >> 3, h = bh & 7;
                    const size_t rowq = (size_t)b * SEQ + 256 * qb, rowk = (size_t)b * SEQ;
                    bf16_t* qn = (bf16_t*)(ws + WS_QN) + rowq * 1024 + h * 128;
#ifndef NO_AT
                    attn_unit<128, 64, 128, true, 2>(lds, qn, 1024, (const bf16_t*)(ws + WS_QR) + rowq * 512 + h * 64, 512,
                        (const bf16_t*)(ws + WS_KN) + rowk * 1024 + h * 128, 1024, (const bf16_t*)(ws + WS_MISC) + rowk * 256, 256,
                        (const bf16_t*)(ws + WS_VA) + rowk * 1024 + h * 128, 1024, (const bf16_t*)(ws + WS_AZ) + rowq * 1024 + h * 128, 1024, qn, 1024,
                        4 * qb + 4, qb, 0.07216878364870322f * 1.4426950408889634f);
#endif
                } else if (ui < U_ML + U_AT + U_CA) {
                    const int r = ui - U_ML - U_AT, qb = r & 15, bh = r >> 4, b = bh >> 2, h = bh & 3;
                    const size_t rowq = (size_t)b * SEQ + 128 * qb, rowk = (size_t)b * NMEM;
                    bf16_t* cq = (bf16_t*)(ws + WS_CQ) + rowq * 1024 + h * 256;
#ifndef NO_CA
                    attn_unit<256, 0, 256, false, 1>(lds, cq, 1024, nullptr, 0,
                        (const bf16_t*)(ws + WS_MKK) + rowk * 1024 + h * 256, 1024, nullptr, 0,
                        (const bf16_t*)(ws + WS_MKV) + rowk * 1024 + h * 256, 1024, (const bf16_t*)(ws + WS_CZ) + rowq * 1024 + h * 256, 1024, cq, 1024,
                        4, 0, 0.0625f * 1.4426950408889634f);
#endif
                } else {
                    const int lane = opaque_tid() & 63;
                    const int r = ui - U_ML - U_AT - U_CA, mat = r >> 7, item = (r & 127) * 8 + wid;
                    if (mat < 3) { const float* W = mat == 0 ? A.w_br_m : (mat == 1 ? A.w_br_a : A.w_br_c);
                        transpose_item(W, 1024, 2048, (bf16_t*)(ws + WS_WBRT + (size_t)mat * 4 * MiB), MAT_ID, nullptr, scr, item, 64, lane); }
                    else transpose_item(A.w_out, 2048, 2048, (bf16_t*)(ws + WS_WOUTT), MAT_ID, nullptr, scr, (mat - 3) * 1024 + item, 64, lane);
                }
            }
            GRID_SYNC();
            {
                const int lane = opaque_tid() & 63;
                bf16_t* mv = (bf16_t*)(dob + DO_MV); const bf16_t* mo = (const bf16_t*)(dob + DO_MO); const bf16_t* mz = (const bf16_t*)(ws + WS_MZ);
                for (int m = gw; m < MTOK; m += NGW) {
                    const size_t off = (size_t)m * 1024 + lane * 16;
                    const bf16_t* hr = (const bf16_t*)(ws + hraw_off(m >> 11)) + ((size_t)((lane >> 4) * 8 + ((lane & 15) >> 1)) * 2048 + (m & 2047)) * 32 + (lane & 1) * 16;
                    const u32x4 h0 = *(const u32x4*)hr, h1 = *(const u32x4*)(hr + 8);
                    const u32x4 o0 = *(const u32x4*)(mo + off), o1 = *(const u32x4*)(mo + off + 8);
                    const u32x4 z0 = *(const u32x4*)(mz + off), z1 = *(const u32x4*)(mz + off + 8);
                    float hv[16], ov[16], zv[16];
                    const unsigned hw[8] = {h0.x, h0.y, h0.z, h0.w, h1.x, h1.y, h1.z, h1.w}, ow[8] = {o0.x, o0.y, o0.z, o0.w, o1.x, o1.y, o1.z, o1.w}, zw[8] = {z0.x, z0.y, z0.z, z0.w, z1.x, z1.y, z1.z, z1.w};
                    float s = 0.f;
#pragma unroll
                    for (int j = 0; j < 8; ++j) { hv[2 * j] = bflo(hw[j]); hv[2 * j + 1] = bfhi(hw[j]); ov[2 * j] = bflo(ow[j]); ov[2 * j + 1] = bfhi(ow[j]); zv[2 * j] = bflo(zw[j]); zv[2 * j + 1] = bfhi(zw[j]);
                        s += hv[2 * j] * hv[2 * j] + hv[2 * j + 1] * hv[2 * j + 1]; }
                    s += __shfl_xor(s, 1); s += __shfl_xor(s, 2); s += __shfl_xor(s, 4); s += __shfl_xor(s, 8);
                    const float rstd = 1.0f / sqrtf(s * (1.0f / 256.0f) + EPS);
                    const float* gp = A.mh_norm + lane * 16;
                    unsigned ow2[8];
#pragma unroll
                    for (int j = 0; j < 8; ++j) {
                        const float a = hv[2 * j] * rstd * gp[2 * j] * sigmoidf_(ov[2 * j]) * siluf_(zv[2 * j]);
                        const float bq = hv[2 * j + 1] * rstd * gp[2 * j + 1] * sigmoidf_(ov[2 * j + 1]) * siluf_(zv[2 * j + 1]);
                        ow2[j] = pk2(a, bq);
                    }
                    *(u32x4*)(mv + off) = (u32x4){ow2[0], ow2[1], ow2[2], ow2[3]};
                    *(u32x4*)(mv + off + 8) = (u32x4){ow2[4], ow2[5], ow2[6], ow2[7]};
                }
            }
            GRID_SYNC();

    }
    for (int gi = 4; gi < 8; ++gi) {
        unsigned char* ws = A.ws; unsigned char* dob = (unsigned char*)A.out; asm volatile("" : "+s"(ws), "+s"(dob));
        pg8::Gemm g; pg8::StaticOrder S; EpiUni E; E.mode = 0; E.mkv_need = (G == 256) ? 64 : 0; E.ws = ws; E.dob = dob; E.x = A.x; E.out = A.out; E.br = 0; E.fg = A.final_norm; E.xl = lds + 131072;
        bool run = true;
        switch (gi) {
            case 0: g = pg8::Gemm{(const pg8::bf16_t*)(ws + WS_MEMN), (const pg8::bf16_t*)(ws + WS_WMKVT), NB * NMEM, 2048, 2048}; E.mode = GM_MKV;
                    if (G >= 128) { run = bx >= G - gb; S.init(g.M, g.N, gb, bx - (G - gb)); } else S.init(g.M, g.N, G, bx); break;
            case 1: g = pg8::Gemm{(const pg8::bf16_t*)(ws + WS_HBF), (const pg8::bf16_t*)(ws + WS_WINT), MTOK, IN_PAD, 2048}; E.mode = GM_INPROJ; S.init(g.M, g.N, G, bx); break;
            case 2: g = pg8::Gemm{(const pg8::bf16_t*)(ws + WS_ACQ), (const pg8::bf16_t*)(ws + WS_WQT), MTOK, 1536, 512}; E.mode = GM_Q; S.init(g.M, g.N, G, bx); break;
            case 3: g = pg8::Gemm{(const pg8::bf16_t*)(ws + WS_ACKV), (const pg8::bf16_t*)(ws + WS_WKVT), MTOK, 2048, 512}; E.mode = GM_KV; S.init(g.M, g.N, G, bx); break;
            case 4: case 5: case 6: {
                const int br = gi - 4;
                const unsigned char* ap = (br == 0) ? (dob + DO_MV) : (br == 1 ? ws + WS_QN : ws + WS_CQ);
                g = pg8::Gemm{(const pg8::bf16_t*)ap, (const pg8::bf16_t*)(ws + WS_WBRT + (size_t)br * 4 * MiB), MTOK, 2048, 1024}; E.mode = GM_BR; E.br = br; S.init(g.M, g.N, G, bx); break; }
            default: g = pg8::Gemm{(const pg8::bf16_t*)(ws + WS_MERGED), (const pg8::bf16_t*)(ws + WS_WOUTT), MTOK, 2048, 2048}; E.mode = GM_OUT; S.init(g.M, g.N, G, bx); break;
        }
#ifndef NO_GEMM
        if (gi == 4) {
            g.dA1 = (const char*)(ws + WS_QN) - (const char*)g.A; g.dA2 = (long)WS_CQ - (long)WS_QN; g.dB1 = (long)(4 * MiB); g.dB2 = (long)(4 * MiB);
            S.chain = 1; E.mode = GM_BRC; pg8::gemm_phase<EpiUni, pg8::StaticOrder, true, true>(lds, g, S, E);
        } else if (gi == 5 || gi == 6) {
        } else
        if (gi == 7 && G == 256) {
            E.mode = GM_OUTF;
            S.prow = 0; pg8::gemm_phase<EpiUni, pg8::StaticOrder, true, true>(lds, g, S, E);
            S.prow = 1; pg8::gemm_phase<EpiUni, pg8::StaticOrder, true, true>(lds, g, S, E);
        } else
        if (run) pg8::gemm_phase<EpiUni, pg8::StaticOrder, true, true>(lds, g, S, E);
#endif
        if (gi == 0 || gi == 1 || gi == 6) GRID_SYNC();
    }
    if (G == 256) return;
    GRID_SYNC();
    const int lane = opaque_tid() & 63;
    for (int m = gw; m < MTOK; m += NGW) {
        f32x4* xr = (f32x4*)(A.out + (size_t)m * DM) + lane;
        f32x4 v[8]; float s = 0.f;
#pragma unroll
        for (int j = 0; j < 8; ++j) { v[j] = xr[64 * j]; s += (v[j][0] * v[j][0] + v[j][1] * v[j][1]) + (v[j][2] * v[j][2] + v[j][3] * v[j][3]); }
        const float rstd = 1.0f / sqrtf(wave_sum(s) * (1.0f / 2048.0f) + EPS);
        const f32x4* gr = (const f32x4*)A.final_norm + lane;
#pragma unroll
        for (int j = 0; j < 8; ++j) xr[64 * j] = v[j] * rstd * gr[64 * j];
    }
}

extern "C" void kernel_launch(void* const* d_in, const int* in_sizes, int n_in, void* d_out, int out_size, void* d_ws, size_t ws_size, hipStream_t stream) {
    static int grid = 0;
    if (grid == 0) {
        if (n_in != 21 || ws_size < WS_NEED) { fprintf(stderr, "kernel_launch: unexpected inputs (n_in %d, ws %zu)\n", n_in, ws_size); grid = -1; return; }
        int dev = 0, cus = 0, per_cu = 0;
        hipGetDevice(&dev);
        hipDeviceGetAttribute(&cus, hipDeviceAttributeMultiprocessorCount, dev);
        if (hipFuncSetAttribute((const void*)fwd_megakernel, hipFuncAttributeMaxDynamicSharedMemorySize, LDS_BYTES) != hipSuccess) { fprintf(stderr, "kernel_launch: hipFuncSetAttribute failed\n"); grid = -1; return; }
        hipOccupancyMaxActiveBlocksPerMultiprocessor(&per_cu, (const void*)fwd_megakernel, NTHR, LDS_BYTES);
        (void)hipGetLastError();
        if (per_cu < 1) per_cu = 1;
        grid = cus * 1;
        if (grid <= 0) { grid = -1; return; }
    }
    if (grid < 0) return;
    Args a{};
    a.x = (const float*)d_in[0]; a.mem = (const float*)d_in[1]; a.pos = (const int*)d_in[2]; a.w_in = (const float*)d_in[3]; a.b_ig = (const float*)d_in[4]; a.b_fg = (const float*)d_in[5];
    a.conv_w = (const float*)d_in[6]; a.conv_b = (const float*)d_in[7]; a.mh_norm = (const float*)d_in[8]; a.cq_norm = (const float*)d_in[9]; a.w_uq = (const float*)d_in[10];
    a.ckv_norm = (const float*)d_in[11]; a.w_ukv = (const float*)d_in[12]; a.mem_norm = (const float*)d_in[13]; a.w_mem_kv = (const float*)d_in[14];
    a.w_br_m = (const float*)d_in[15]; a.w_br_a = (const float*)d_in[16]; a.w_br_c = (const float*)d_in[17]; a.w_out = (const float*)d_in[18]; a.norm = (const float*)d_in[19]; a.final_norm = (const float*)d_in[20];
    a.out = (float*)d_out; a.ws = (unsigned char*)d_ws;
    if (hipMemsetAsync(d_ws, 0, CTL_ZERO_BYTES, stream) != hipSuccess) { fprintf(stderr, "memset failed\n"); return; }
    void* args[] = {&a};
    hipError_t e = hipLaunchCooperativeKernel((const void*)fwd_megakernel, dim3(grid), dim3(NTHR), args, LDS_BYTES, stream);
    if (e != hipSuccess) fprintf(stderr, "cooperative launch failed: %s (grid %d)\n", hipGetErrorString(e), grid);
}
```

```cpp
#include <hip/hip_runtime.h>
#include <hip/hip_cooperative_groups.h>
#include <cstdio>
#include <cstdint>
namespace cg = cooperative_groups;
__device__ __forceinline__ int opaque_tid() { int t = threadIdx.x; asm volatile("" : "+v"(t)); return t; }
namespace pg8 {
#define PG8_LAS __attribute__((address_space(3)))
typedef unsigned short bf16_t;
typedef short bf16x8 __attribute__((ext_vector_type(8)));
typedef float f32x4 __attribute__((ext_vector_type(4)));
typedef unsigned u32x4 __attribute__((ext_vector_type(4)));
constexpr int BM = 256, BK = 64, HALF = 128, HTB = HALF * BK * 2  , STAGE_BYTES = 8 * HTB, NXCD = 8, WGM = 8;

__host__ __device__ __forceinline__ int lds_byte(int r, int c) { const int st = (r >> 4) * 2 + (c >> 5), rr = r & 15, cc = c & 31, ob = rr * 64 + cc * 2; return st * 1024 + (ob ^ (((ob >> 9) & 1) << 5)); }
__host__ __device__ __forceinline__ void stage_rc(int b, int& R, int& C) { const int st = b / 1024, sb = b % 1024, swz = sb ^ (((sb >> 9) & 1) << 5); R = (st >> 1) * 16 + swz / 64; C = (st & 1) * 32 + (swz % 64) / 2; }
__host__ __device__ __forceinline__ int perm32(int rho) { const int n = rho >> 4, i = rho & 15; return 8 * (i >> 2) + 4 * n + (i & 3); }

struct Unit { int pm, pn, sel = 0, cont = 0; };
struct Gemm { const bf16_t* A; const bf16_t* Bt; int M, N, K; long dA1 = 0, dA2 = 0, dB1 = 0, dB2 = 0;
    __device__ __forceinline__ const char* a(int sel) const { return (const char*)A + (sel > 0 ? dA1 : 0l) + (sel > 1 ? dA2 : 0l); }
    __device__ __forceinline__ const char* b(int sel) const { return (const char*)Bt + (sel > 0 ? dB1 : 0l) + (sel > 1 ? dB2 : 0l); } };

struct StaticOrder {
    int nM, nN, nwg, G, c, chain = 0, prow = -1;
    __host__ __device__ void init(int M, int N, int G_, int c_) { nM = M / BM; nN = N / BM; nwg = nM * nN; G = G_; c = c_; prow = -1; chain = 0; }
    __host__ __device__ __forceinline__ void next_plain(int L, Unit& u) const {
        int wgid = L; { const int q = nwg / NXCD, r = nwg % NXCD, xcd = wgid % NXCD, off = wgid / NXCD; wgid = (xcd < r ? xcd * (q + 1) : r * (q + 1) + (xcd - r) * q) + off; }
        const int nig = WGM * nN, gid = wgid / nig, fm = gid * WGM, gsz = (nM - fm) < WGM ? (nM - fm) : WGM;
        u.pm = fm + ((wgid % nig) % gsz); u.pn = (wgid % nig) / gsz; u.sel = 0; u.cont = 0; }
    __host__ __device__ __forceinline__ bool next(int i, Unit& u) const {
        if (chain) { const int ti = i / 3; const long Lc = (long)ti * G + c; if (Lc >= nwg) return false; next_plain((int)Lc, u); u.sel = i - 3 * ti; u.cont = u.sel > 0; return true; }
        if (prow >= 0) { if (i > 0) return false; const int off = c >> 3; u.pm = prow * 32 + (c & 7) * 4 + (off >> 3); u.pn = off & 7; return true; }
        const long L = (long)i * G + c; if (L >= nwg) return false;
        int wgid = (int)L; { const int q = nwg / NXCD, r = nwg % NXCD, xcd = wgid % NXCD, off = wgid / NXCD; wgid = (xcd < r ? xcd * (q + 1) : r * (q + 1) + (xcd - r) * q) + off; }
        const int nig = WGM * nN, gid = wgid / nig, fm = gid * WGM, gsz = (nM - fm) < WGM ? (nM - fm) : WGM;
        u.pm = fm + ((wgid % nig) % gsz); u.pn = (wgid % nig) / gsz; return true;
    }
    __device__ __forceinline__ void a_ready(const Unit&) const {}
    __device__ __forceinline__ void done(const Unit&) const {}
};

__device__ __forceinline__ unsigned cvt_pk_bf16(float lo, float hi) { unsigned r; asm volatile("v_cvt_pk_bf16_f32 %0, %1, %2" : "=v"(r) : "v"(lo), "v"(hi)); return r; }
template <class Epi, class Sched, bool ALIGN_EPI = false, bool SP2 = false>
__device__ __forceinline__ void gemm_phase(PG8_LAS unsigned char* lds, const Gemm g, const Sched& S, const Epi& E) {
    const int tid = opaque_tid(), wid = __builtin_amdgcn_readfirstlane(tid >> 6), lane = tid & 63, wr = wid >> 2, wc = wid & 3, fr = lane & 15, fq = lane >> 4;
    const int K = g.K, nt = K / BK;
    unsigned voffA[2], voffB[2];
#pragma unroll
    for (int i = 0; i < 2; ++i) { int R, C; stage_rc(tid * 16 + i * 8192, R, C); const int Rb = Epi::PERM ? ((R & ~31) + perm32(R & 31)) : R;
        voffA[i] = (unsigned)(R * K + C) * 2u; voffB[i] = (unsigned)(Rb * K + C) * 2u; }
    const size_t kstep = (size_t)(BK * 2);
    const size_t hstep = (size_t)HALF * K * 2;
    const size_t tstep = 2 * hstep;
    const unsigned ldsw = (unsigned)wid * 1024u;
    const int aoff = lds_byte(wr * 64 + fr, fq * 8), boff = lds_byte(wc * 32 + fr, fq * 8);
#define PG8_SA(b, h) (((b) * 2 + (h)) * HTB)
#define PG8_SB(b, h) ((4 + (b) * 2 + (h)) * HTB)
#define PG8_STAGE(bufoff, gbase, voff) do { _Pragma("unroll") for (int _i = 0; _i < 2; ++_i) \
        __builtin_amdgcn_global_load_lds((const unsigned*)((const char*)(gbase) + (voff)[_i]), (PG8_LAS unsigned*)(lds + (bufoff) + ldsw + _i * 8192), 16, 0, 0); } while (0)
#define PG8_LDA(dst, b, h) do { _Pragma("unroll") for (int m = 0; m < 4; ++m) _Pragma("unroll") for (int k = 0; k < 2; ++k) dst[m][k] = *(const PG8_LAS bf16x8*)(lds + PG8_SA(b, h) + aoff + m * 2048 + k * 1024); } while (0)
#define PG8_LDB(dst, b, h) do { _Pragma("unroll") for (int n = 0; n < 2; ++n) _Pragma("unroll") for (int k = 0; k < 2; ++k) dst[n][k] = *(const PG8_LAS bf16x8*)(lds + PG8_SB(b, h) + boff + n * 2048 + k * 1024); } while (0)
#define PG8_MMA(ai, bj, At, Bt) do { __builtin_amdgcn_s_setprio(1); _Pragma("unroll") for (int m = 0; m < 4; ++m) _Pragma("unroll") for (int n = 0; n < 2; ++n) _Pragma("unroll") for (int k = 0; k < 2; ++k) \
        acc[ai][bj][m][n] = __builtin_amdgcn_mfma_f32_16x16x32_bf16(Bt[n][k], At[m][k], acc[ai][bj][m][n], 0, 0, 0); __builtin_amdgcn_s_setprio(0); } while (0)
#define PG8_WAIT_V(n) asm volatile("s_waitcnt vmcnt(" #n ")" ::: "memory")
#define PG8_WAIT_L(n) asm volatile("s_waitcnt lgkmcnt(" #n ")" ::: "memory")
#define PG8_BAR __builtin_amdgcn_s_barrier()
#define PG8_SCHED __builtin_amdgcn_sched_barrier(0)
    Unit cur, nxt; int ui = 0;
    if (!S.next(0, cur)) return;
    f32x4 acc[2][2][4][2];
#pragma unroll
    for (int a = 0; a < 2; ++a)
#pragma unroll
        for (int b = 0; b < 2; ++b)
#pragma unroll
            for (int m = 0; m < 4; ++m)
#pragma unroll
                for (int n = 0; n < 2; ++n) acc[a][b][m][n] = (f32x4){0.f, 0.f, 0.f, 0.f};
    bf16x8 At[4][2], B0[2][2], B1[2][2];
    const char* cA = g.a(cur.sel) + (size_t)cur.pm * tstep; const char* cB = g.b(cur.sel) + (size_t)cur.pn * tstep;
    S.a_ready(cur);
    if constexpr (SP2) {
        PG8_STAGE(PG8_SB(0, 0), cB, voffB); PG8_STAGE(PG8_SB(0, 1), cB + hstep, voffB); PG8_STAGE(PG8_SA(0, 0), cA, voffA); PG8_STAGE(PG8_SA(0, 1), cA + hstep, voffA);
        if (wr == 1) PG8_BAR;
        PG8_WAIT_V(2); PG8_BAR;
        PG8_STAGE(PG8_SB(1, 0), cB + kstep, voffB); PG8_STAGE(PG8_SA(1, 0), cA + kstep, voffA); PG8_STAGE(PG8_SB(1, 1), cB + hstep + kstep, voffB);
        PG8_WAIT_V(6); PG8_BAR;
    } else {
        PG8_STAGE(PG8_SB(0, 0), cB, voffB); PG8_STAGE(PG8_SA(0, 0), cA, voffA); PG8_STAGE(PG8_SB(0, 1), cB + hstep, voffB); PG8_STAGE(PG8_SA(0, 1), cA + hstep, voffA);
        if (wr == 1) PG8_BAR;
        PG8_WAIT_V(4); PG8_BAR;
        PG8_STAGE(PG8_SB(1, 0), cB + kstep, voffB); PG8_STAGE(PG8_SA(1, 0), cA + kstep, voffA); PG8_STAGE(PG8_SB(1, 1), cB + hstep + kstep, voffB);
        PG8_WAIT_V(6); PG8_BAR;
    }
    for (;;) {
        const bool has_next = S.next(ui + 1, nxt);
        const char* nA = has_next ? g.a(nxt.sel) + (size_t)nxt.pm * tstep : cA; const char* nB = has_next ? g.b(nxt.sel) + (size_t)nxt.pn * tstep : cB;
        for (int t = 0; t < nt; t += 2) {
            const bool last = (t == nt - 2);
            const char* a1 = cA + (size_t)(t + 1) * kstep;
            const char* a2 = last ? nA : cA + (size_t)(t + 2) * kstep; const char* b2 = last ? nB : cB + (size_t)(t + 2) * kstep;
            const char* a3 = a2 + kstep; const char* b3 = b2 + kstep;
            if (last && has_next) S.a_ready(nxt);
            if constexpr (SP2) {
            PG8_LDB(B0, 0, 0); PG8_LDB(B1, 0, 1); PG8_SCHED; PG8_LDA(At, 0, 0); PG8_STAGE(PG8_SA(1, 1), a1 + hstep, voffA);
            PG8_WAIT_V(8); PG8_WAIT_L(0); PG8_BAR; PG8_MMA(0, 0, At, B0); PG8_MMA(0, 1, At, B1); PG8_BAR; PG8_SCHED;
            PG8_LDA(At, 0, 1); PG8_STAGE(PG8_SB(0, 0), b2, voffB); PG8_STAGE(PG8_SB(0, 1), b2 + hstep, voffB); PG8_STAGE(PG8_SA(0, 0), a2, voffA);
            PG8_WAIT_V(8); PG8_WAIT_L(0); PG8_BAR; PG8_MMA(1, 0, At, B0); PG8_MMA(1, 1, At, B1); PG8_BAR; PG8_SCHED;
            PG8_LDB(B0, 1, 0); PG8_LDB(B1, 1, 1); PG8_SCHED; PG8_LDA(At, 1, 0); PG8_STAGE(PG8_SA(0, 1), a2 + hstep, voffA);
            PG8_WAIT_V(8); PG8_WAIT_L(0); PG8_BAR; PG8_MMA(0, 0, At, B0); PG8_MMA(0, 1, At, B1); PG8_BAR; PG8_SCHED;
            PG8_LDA(At, 1, 1); PG8_STAGE(PG8_SB(1, 0), b3, voffB); PG8_STAGE(PG8_SB(1, 1), b3 + hstep, voffB); PG8_STAGE(PG8_SA(1, 0), a3, voffA);
            PG8_WAIT_V(8); PG8_WAIT_L(0); PG8_BAR; PG8_MMA(1, 0, At, B0); PG8_MMA(1, 1, At, B1); PG8_BAR; PG8_SCHED;
            } else {
            PG8_LDB(B0, 0, 0); PG8_SCHED; PG8_LDA(At, 0, 0); PG8_STAGE(PG8_SA(1, 1), a1 + hstep, voffA);
            PG8_WAIT_L(8); PG8_BAR; PG8_WAIT_L(0); PG8_MMA(0, 0, At, B0); PG8_BAR; PG8_SCHED;
            PG8_LDB(B1, 0, 1); PG8_STAGE(PG8_SB(0, 0), b2, voffB);
            PG8_BAR; PG8_WAIT_L(0); PG8_MMA(0, 1, At, B1); PG8_BAR;
            PG8_LDA(At, 0, 1); PG8_STAGE(PG8_SA(0, 0), a2, voffA);
            PG8_BAR; PG8_WAIT_L(0); PG8_MMA(1, 0, At, B0); PG8_BAR; PG8_SCHED;
            PG8_STAGE(PG8_SB(0, 1), b2 + hstep, voffB);
            PG8_WAIT_V(6); PG8_BAR; PG8_MMA(1, 1, At, B1); PG8_BAR;
            PG8_LDB(B0, 1, 0); PG8_SCHED; PG8_LDA(At, 1, 0); PG8_STAGE(PG8_SA(0, 1), a2 + hstep, voffA);
            PG8_WAIT_L(8); PG8_BAR; PG8_WAIT_L(0); PG8_MMA(0, 0, At, B0); PG8_BAR; PG8_SCHED;
            PG8_LDB(B1, 1, 1); PG8_STAGE(PG8_SB(1, 0), b3, voffB);
            PG8_BAR; PG8_WAIT_L(0); PG8_MMA(0, 1, At, B1); PG8_BAR;
            PG8_LDA(At, 1, 1); PG8_STAGE(PG8_SA(1, 0), a3, voffA);
            PG8_BAR; PG8_WAIT_L(0); PG8_MMA(1, 0, At, B0); PG8_BAR; PG8_SCHED;
            PG8_STAGE(PG8_SB(1, 1), b3 + hstep, voffB);
            PG8_WAIT_V(6); PG8_BAR; PG8_MMA(1, 1, At, B1); PG8_BAR;
            }
        }
        if constexpr (ALIGN_EPI) { if (wr == 0) PG8_BAR; }
        if constexpr (!Epi::AFTER_DRAIN) { E(acc, cur, wr, wc, fr, fq); S.done(cur); }
        if (!has_next) break;
        if (!nxt.cont) {
#pragma unroll
        for (int a = 0; a < 2; ++a)
#pragma unroll
            for (int b = 0; b < 2; ++b)
#pragma unroll
                for (int m = 0; m < 4; ++m)
#pragma unroll
                    for (int n = 0; n < 2; ++n) acc[a][b][m][n] = (f32x4){0.f, 0.f, 0.f, 0.f};
        }
        cur = nxt; cA = nA; cB = nB; ++ui;
        if constexpr (ALIGN_EPI) { if (wr == 1) PG8_BAR; }
    }
    PG8_WAIT_V(0);
    if constexpr (!ALIGN_EPI) { if (wr == 0) PG8_BAR; }
    PG8_BAR;
    if constexpr (Epi::AFTER_DRAIN) { E.fused(acc, cur, wr, wc, fr, fq, lds, wid, lane); S.done(cur); }
#undef PG8_SA
#undef PG8_SB
#undef PG8_STAGE
#undef PG8_LDA
#undef PG8_LDB
#undef PG8_MMA
#undef PG8_WAIT_V
#undef PG8_WAIT_L
#undef PG8_BAR
#undef PG8_SCHED
}
}

#define LAS __attribute__((address_space(3)))
typedef unsigned short bf16_t;
typedef short bf16x8 __attribute__((ext_vector_type(8)));
typedef short s16x4 __attribute__((ext_vector_type(4)));
typedef float f32x4 __attribute__((ext_vector_type(4)));
typedef unsigned u32x4 __attribute__((ext_vector_type(4)));
typedef unsigned u32x2 __attribute__((ext_vector_type(2)));

constexpr int NWAVES = 8, NTHR = 512;
constexpr int DM = 2048, NB = 8, SEQ = 2048, MTOK = NB * SEQ;
constexpr int IN_DIM = 15432, IN_PAD = 15616;
constexpr int NMEM = 256;
constexpr float EPS = 1e-6f;
constexpr size_t MiB = 1u << 20;

constexpr size_t WS_CTL = 0;
constexpr size_t WS_CS = 1 * MiB;
constexpr size_t WS_WQT = 5 * MiB;
constexpr size_t WS_WKVT = 6 * MiB + 512 * 1024;
constexpr size_t WS_MKK = 9 * MiB;
constexpr size_t WS_MKV = 13 * MiB;
constexpr size_t WS_MZ = 17 * MiB;
constexpr size_t WS_ACQ = 49 * MiB;
constexpr size_t WS_ACKV = 65 * MiB;
constexpr size_t WS_WBRT = 49 * MiB;
constexpr size_t WS_WOUTT = 61 * MiB;
constexpr size_t WS_AZ = 81 * MiB;
constexpr size_t WS_CQ = 113 * MiB;
constexpr size_t WS_CZ = 145 * MiB;
constexpr size_t WS_GATES = 177 * MiB;
constexpr size_t WS_WMKVT = 177 * MiB;
constexpr size_t WS_MEMN = 185 * MiB;
constexpr size_t WS_MISC = 369 * MiB;
constexpr size_t WS_HBF = 377 * MiB;
constexpr size_t WS_WINT = 441 * MiB;
constexpr size_t WS_QN = 377 * MiB;
constexpr size_t WS_QR = 409 * MiB;
constexpr size_t WS_KN = 425 * MiB;
constexpr size_t WS_VA = 457 * MiB;
constexpr size_t WS_MERGED = 425 * MiB;
constexpr size_t WS_SSQ = 503 * MiB;
constexpr size_t WS_HALO = 504 * MiB;
constexpr size_t WS_NEED = 512 * MiB;
constexpr size_t DO_QK = 0, DO_MV = 64 * MiB, DO_MO = 96 * MiB;
constexpr int CW_QUEUE = 0;
constexpr int CW_MKVDONE = 64;
constexpr int CW_PANEL = 8192;
constexpr size_t WS_XS = 256 * 1024;
constexpr int CW_BAR = 4096;
constexpr size_t CTL_ZERO_BYTES = 65536;

constexpr int LDS_BYTES = 163840;

struct Args {
    const float* x; const float* mem; const int* pos; const float* w_in; const float* b_ig; const float* b_fg; const float* conv_w; const float* conv_b;
    const float* mh_norm; const float* cq_norm; const float* w_uq; const float* ckv_norm; const float* w_ukv; const float* mem_norm; const float* w_mem_kv;
    const float* w_br_m; const float* w_br_a; const float* w_br_c; const float* w_out; const float* norm; const float* final_norm;
    float* out; unsigned char* ws;
};

__device__ __forceinline__ unsigned f2bf(float f) { unsigned u = __builtin_bit_cast(unsigned, f); return (u + 0x7fffu + ((u >> 16) & 1u)) >> 16; }
typedef float f32x2_t __attribute__((ext_vector_type(2))); typedef __bf16 bf16x2_t __attribute__((ext_vector_type(2)));
__device__ __forceinline__ unsigned pk2(float lo, float hi) { f32x2_t v = {lo, hi}; bf16x2_t b = __builtin_convertvector(v, bf16x2_t); return __builtin_bit_cast(unsigned, b); }
__device__ __forceinline__ float bflo(unsigned w) { return __builtin_bit_cast(float, w << 16); }
__device__ __forceinline__ float bfhi(unsigned w) { return __builtin_bit_cast(float, w & 0xffff0000u); }
__device__ __forceinline__ float bf2f(bf16_t h) { return __builtin_bit_cast(float, (unsigned)h << 16); }
__device__ __forceinline__ float wave_sum(float v) {
#pragma unroll
    for (int o = 1; o < 64; o <<= 1) v += __shfl_xor(v, o);
    return v;
}
__device__ __forceinline__ float sigmoidf_(float v) { return __builtin_amdgcn_rcpf(1.0f + __builtin_amdgcn_exp2f(-1.4426950408889634f * v)); }
__device__ __forceinline__ float siluf_(float v) { return v * __builtin_amdgcn_rcpf(1.0f + __builtin_amdgcn_exp2f(-1.4426950408889634f * v)); }
#define LDS_WAIT() asm volatile("s_waitcnt lgkmcnt(0)" ::: "memory")
#define MFMA16(a, b, c) __builtin_amdgcn_mfma_f32_16x16x32_bf16((a), (b), (c), 0, 0, 0)

enum { GM_MKV = 0, GM_INPROJ = 1, GM_Q = 2, GM_KV = 3, GM_BR = 4, GM_OUT = 5, GM_OUTF = 6, GM_BRC = 7 };
struct EpiUni {
    static constexpr bool PERM = true, AFTER_DRAIN = false;
    int mode, br, mkv_need; unsigned char* ws; unsigned char* dob; const float* x; float* out; const float* fg; LAS unsigned char* xl;
    __device__ __forceinline__ void operator()(const f32x4 (&acc)[2][2][4][2], const pg8::Unit& u, int wr, int wc, int fr, int fq) const {
        const int row0 = u.pm * 256 + wr * 64 + fr;
        const int cl0 = wc * 32 + 8 * fq;
        if (mode <= GM_KV) {
            bf16_t* base; int ld, col0; float* ssq = nullptr; const float* rs = nullptr; int rope = 0; bool halo = false;
            const int pn = u.pn;
            if (mode == GM_INPROJ) {
                if (pn < 8) { base = (bf16_t*)(dob + DO_QK); ld = 2048; col0 = pn * 256; halo = true; }
                else if (pn < 12) { base = (bf16_t*)(dob + DO_MV); ld = 1024; col0 = (pn - 8) * 256; }
                else if (pn < 16) { base = (bf16_t*)(dob + DO_MO); ld = 1024; col0 = (pn - 12) * 256; }
                else if (pn < 20) { base = (bf16_t*)(ws + WS_MZ); ld = 1024; col0 = (pn - 16) * 256; }
                else if (pn < 22) { base = (bf16_t*)(ws + WS_ACQ); ld = 512; col0 = (pn - 20) * 256; ssq = (float*)(ws + WS_SSQ) + (pn - 20) * 4 + wc; }
                else if (pn < 24) { base = (bf16_t*)(ws + WS_ACKV); ld = 512; col0 = (pn - 22) * 256; ssq = (float*)(ws + WS_SSQ) + MTOK * 8 + (pn - 22) * 4 + wc; }
                else if (pn < 28) { base = (bf16_t*)(ws + WS_AZ); ld = 1024; col0 = (pn - 24) * 256; }
                else if (pn < 32) { base = (bf16_t*)(ws + WS_CQ); ld = 1024; col0 = (pn - 28) * 256; }
                else if (pn < 36) { base = (bf16_t*)(ws + WS_CZ); ld = 1024; col0 = (pn - 32) * 256; }
                else if (pn < 60) { base = (bf16_t*)(ws + WS_GATES); ld = 6144; col0 = (pn - 36) * 256;
                    if (mkv_need) { unsigned spin = 0; while ((unsigned)__builtin_amdgcn_readfirstlane(__hip_atomic_load((unsigned*)(ws + WS_CTL) + CW_MKVDONE, __ATOMIC_RELAXED, __HIP_MEMORY_SCOPE_AGENT)) < (unsigned)mkv_need && ++spin < (1u << 22)) __builtin_amdgcn_s_sleep(4); } }
                else { base = (bf16_t*)(ws + WS_MISC); ld = 256; col0 = 0; rope = 1; }
            } else if (mode == GM_MKV) {
                if (pn < 4) { base = (bf16_t*)(ws + WS_MKK); ld = 1024; col0 = pn * 256; }
                else { base = (bf16_t*)(ws + WS_MKV); ld = 1024; col0 = (pn - 4) * 256; }
            } else if (mode == GM_Q) {
                rs = (const float*)(ws + WS_SSQ);
                if (pn < 4) { base = (bf16_t*)(ws + WS_QN); ld = 1024; col0 = pn * 256; }
                else { base = (bf16_t*)(ws + WS_QR); ld = 512; col0 = (pn - 4) * 256; rope = 2; }
            } else {
                rs = (const float*)(ws + WS_SSQ) + MTOK * 8;
                if (pn < 4) { base = (bf16_t*)(ws + WS_KN); ld = 1024; col0 = pn * 256; }
                else { base = (bf16_t*)(ws + WS_VA); ld = 1024; col0 = (pn - 4) * 256; }
            }
            const float* cs = (const float*)(ws + WS_CS);
            float rstdv[8];
            if (rs) {
                f32x4 pp[8][2];
#pragma unroll
                for (int g8 = 0; g8 < 8; ++g8) { const int row = row0 + (g8 >> 2) * 128 + (g8 & 3) * 16; pp[g8][0] = *(const f32x4*)(rs + (size_t)row * 8); pp[g8][1] = *(const f32x4*)(rs + (size_t)row * 8 + 4); }
#pragma unroll
                for (int g8 = 0; g8 < 8; ++g8) rstdv[g8] = 1.0f / sqrtf((((pp[g8][0][0] + pp[g8][0][1]) + (pp[g8][0][2] + pp[g8][0][3])) + ((pp[g8][1][0] + pp[g8][1][1]) + (pp[g8][1][2] + pp[g8][1][3]))) * (1.0f / 512.0f) + EPS);
            } else {
#pragma unroll
                for (int g8 = 0; g8 < 8; ++g8) rstdv[g8] = 1.0f;
            }
#pragma unroll
            for (int ai = 0; ai < 2; ++ai)
#pragma unroll
                for (int m = 0; m < 4; ++m) {
                    const int row = row0 + ai * 128 + m * 16;
                    const float rstd = rstdv[ai * 4 + m];
                    float sq = 0.f;
#pragma unroll
                    for (int bj = 0; bj < 2; ++bj) {
                        f32x4 v0 = acc[ai][bj][m][0] * rstd, v1 = acc[ai][bj][m][1] * rstd;
                        const int cl = cl0 + bj * 128;
                        sq += (v0[0] * v0[0] + v0[1] * v0[1]) + (v0[2] * v0[2] + v0[3] * v0[3]) + (v1[0] * v1[0] + v1[1] * v1[1]) + (v1[2] * v1[2] + v1[3] * v1[3]);
                        if (rope == 2 || (rope == 1 && cl < 64)) {
                            const int i0 = (cl & 63) >> 1;
                            const f32x4 c01 = *(const f32x4*)(cs + ((size_t)row * 32 + i0) * 2);
                            const f32x4 c23 = *(const f32x4*)(cs + ((size_t)row * 32 + i0 + 2) * 2);
                            f32x4 w0, w1;
                            w0[0] = v0[0] * c01[0] - v0[1] * c01[1]; w0[1] = v0[1] * c01[0] + v0[0] * c01[1];
                            w0[2] = v0[2] * c01[2] - v0[3] * c01[3]; w0[3] = v0[3] * c01[2] + v0[2] * c01[3];
                            w1[0] = v1[0] * c23[0] - v1[1] * c23[1]; w1[1] = v1[1] * c23[0] + v1[0] * c23[1];
                            w1[2] = v1[2] * c23[2] - v1[3] * c23[3]; w1[3] = v1[3] * c23[2] + v1[2] * c23[3];
                            v0 = w0; v1 = w1;
                        }
                        u32x4 w; w.x = pk2(v0[0], v0[1]); w.y = pk2(v0[2], v0[3]); w.z = pk2(v1[0], v1[1]); w.w = pk2(v1[2], v1[3]);
                        *(u32x4*)(base + (size_t)row * ld + col0 + cl) = w;
                        if (halo && (m & 1) && fr >= 13) *(u32x4*)((bf16_t*)(ws + WS_HALO) + ((size_t)(row >> 5) * 3 + (fr - 13)) * 2048 + col0 + cl) = w;
                    }
                    if (ssq) {
                        sq += __shfl_xor(sq, 16); sq += __shfl_xor(sq, 32);
                        if (fq == 0) ssq[(size_t)row * 8] = sq;
                    }
                    asm volatile("" ::: "memory");
                }
        } else if (mode == GM_BR) {
            const bf16_t* gates = (const bf16_t*)(ws + WS_GATES) + (size_t)br * 2048 + u.pn * 256 + cl0; bf16_t* mg = (bf16_t*)(ws + WS_MERGED) + u.pn * 256 + cl0;
#pragma unroll
            for (int hb = 0; hb < 2; ++hb) {
                u32x4 gq[4][2], oq[4][2];
#pragma unroll
                for (int gg = 0; gg < 4; ++gg) { const int row_ = row0 + hb * 128 + gg * 16;
                    gq[gg][0] = *(const u32x4*)(gates + (size_t)row_ * 6144); gq[gg][1] = *(const u32x4*)(gates + (size_t)row_ * 6144 + 128);
                    if (br > 0) { oq[gg][0] = *(const u32x4*)(mg + (size_t)row_ * 2048); oq[gg][1] = *(const u32x4*)(mg + (size_t)row_ * 2048 + 128); } }
#pragma unroll
                for (int gg = 0; gg < 4; ++gg) {
                    const int row = row0 + hb * 128 + gg * 16;
#pragma unroll
                    for (int bj = 0; bj < 2; ++bj) {
                        const u32x4 g = gq[gg][bj];
                        f32x4 v0 = acc[hb][bj][gg][0], v1 = acc[hb][bj][gg][1];
                        v0[0] *= sigmoidf_(bflo(g.x)); v0[1] *= sigmoidf_(bfhi(g.x)); v0[2] *= sigmoidf_(bflo(g.y)); v0[3] *= sigmoidf_(bfhi(g.y));
                        v1[0] *= sigmoidf_(bflo(g.z)); v1[1] *= sigmoidf_(bfhi(g.z)); v1[2] *= sigmoidf_(bflo(g.w)); v1[3] *= sigmoidf_(bfhi(g.w));
                        if (br > 0) {
                            const u32x4 o = oq[gg][bj];
                            v0[0] += bflo(o.x); v0[1] += bfhi(o.x); v0[2] += bflo(o.y); v0[3] += bfhi(o.y);
                            v1[0] += bflo(o.z); v1[1] += bfhi(o.z); v1[2] += bflo(o.w); v1[3] += bfhi(o.w);
                        }
                        u32x4 w; w.x = pk2(v0[0], v0[1]); w.y = pk2(v0[2], v0[3]); w.z = pk2(v1[0], v1[1]); w.w = pk2(v1[2], v1[3]);
                        *(u32x4*)(mg + (size_t)row * 2048 + bj * 128) = w;
                    }
                }
                asm volatile("" ::: "memory");
            }
        } else if (mode == GM_BRC) {
            f32x4 (&a)[2][2][4][2] = const_cast<f32x4 (&)[2][2][4][2]>(acc);
            const int sel = u.sel;
            const bf16_t* ga = (const bf16_t*)(ws + WS_GATES) + (size_t)sel * 2048 + u.pn * 256 + cl0; bf16_t* mg = (bf16_t*)(ws + WS_MERGED) + u.pn * 256 + cl0;
#pragma unroll
            for (int hq4 = 0; hq4 < 4; ++hq4) {
                const int hb = hq4 >> 1, g0 = (hq4 & 1) * 2;
                u32x4 gq[2][2], hq[2][2];
#pragma unroll
                for (int gi2 = 0; gi2 < 2; ++gi2) { const int gg = gi2; const size_t ro = (size_t)(row0 + hb * 128 + (g0 + gi2) * 16) * 6144;
                    gq[gg][0] = *(const u32x4*)(ga + ro); gq[gg][1] = *(const u32x4*)(ga + ro + 128);
                    if (sel < 2) { hq[gg][0] = *(const u32x4*)(ga + ro + 2048); hq[gg][1] = *(const u32x4*)(ga + ro + 2048 + 128); } }
#pragma unroll
                for (int gi2 = 0; gi2 < 2; ++gi2) {
                    const int gg = gi2, gm = g0 + gi2; const int row = row0 + hb * 128 + gm * 16;
#pragma unroll
                    for (int bj = 0; bj < 2; ++bj) {
                        const u32x4 g = gq[gg][bj];
                        float f[8] = {sigmoidf_(bflo(g.x)), sigmoidf_(bfhi(g.x)), sigmoidf_(bflo(g.y)), sigmoidf_(bfhi(g.y)), sigmoidf_(bflo(g.z)), sigmoidf_(bfhi(g.z)), sigmoidf_(bflo(g.w)), sigmoidf_(bfhi(g.w))};
                        if (sel < 2) {
                            const u32x4 hn = hq[gg][bj];
                            const float t[8] = {bflo(hn.x), bfhi(hn.x), bflo(hn.y), bfhi(hn.y), bflo(hn.z), bfhi(hn.z), bflo(hn.w), bfhi(hn.w)};
#pragma unroll
                            for (int e = 0; e < 8; ++e) f[e] *= 1.0f + __builtin_amdgcn_exp2f(-1.4426950408889634f * t[e]);
                        }
                        f32x4 v0 = a[hb][bj][gm][0], v1 = a[hb][bj][gm][1];
                        v0[0] *= f[0]; v0[1] *= f[1]; v0[2] *= f[2]; v0[3] *= f[3]; v1[0] *= f[4]; v1[1] *= f[5]; v1[2] *= f[6]; v1[3] *= f[7];
                        if (sel == 2) {
                            u32x4 w; w.x = pk2(v0[0], v0[1]); w.y = pk2(v0[2], v0[3]); w.z = pk2(v1[0], v1[1]); w.w = pk2(v1[2], v1[3]);
                            *(u32x4*)(mg + (size_t)row * 2048 + bj * 128) = w;
                        } else { a[hb][bj][gm][0] = v0; a[hb][bj][gm][1] = v1; }
                    }
                }
                asm volatile("" ::: "memory");
            }
        } else if (mode == GM_OUTF) {
            f32x4 (&a)[2][2][4][2] = const_cast<f32x4 (&)[2][2][4][2]>(acc);
            LAS float* P = (LAS float*)xl;
            LAS float* R = (LAS float*)(xl + 4096);
            const int tid_ = (wr * 4 + wc) * 64 + fq * 16 + fr;
            const float* xb = x + u.pn * 256 + cl0;
#pragma unroll
            for (int hb = 0; hb < 2; ++hb) {
                f32x4 xq[4][4];
#pragma unroll
                for (int gg = 0; gg < 4; ++gg) { const size_t ro = (size_t)(row0 + hb * 128 + gg * 16) * 2048;
                    xq[gg][0] = *(const f32x4*)(xb + ro); xq[gg][1] = *(const f32x4*)(xb + ro + 4); xq[gg][2] = *(const f32x4*)(xb + ro + 128); xq[gg][3] = *(const f32x4*)(xb + ro + 132); }
#pragma unroll
                for (int gg = 0; gg < 4; ++gg) {
                    const int ai = hb, m = gg;
                    float sq = 0.f;
#pragma unroll
                    for (int bj = 0; bj < 2; ++bj) {
                        const f32x4 v0 = xq[gg][bj * 2] + a[ai][bj][m][0], v1 = xq[gg][bj * 2 + 1] + a[ai][bj][m][1];
                        a[ai][bj][m][0] = v0; a[ai][bj][m][1] = v1;
                        sq += (v0[0] * v0[0] + v0[1] * v0[1]) + (v0[2] * v0[2] + v0[3] * v0[3]) + (v1[0] * v1[0] + v1[1] * v1[1]) + (v1[2] * v1[2] + v1[3] * v1[3]);
                    }
                    sq += __shfl_xor(sq, 16); sq += __shfl_xor(sq, 32);
                    if (fq == 0) P[(wr * 64 + ai * 128 + m * 16 + fr) * 4 + wc] = sq;
                }
                asm volatile("" ::: "memory");
            }
            asm volatile("s_waitcnt lgkmcnt(0)" ::: "memory"); __builtin_amdgcn_s_barrier(); asm volatile("" ::: "memory");
            float* xs = (float*)(ws + WS_XS); unsigned* cnt = (unsigned*)(ws + WS_CTL) + CW_PANEL + 64 * u.pm;
            if (tid_ < 256) {
                const f32x4 p4 = *(const LAS f32x4*)(P + tid_ * 4);
                __hip_atomic_store(xs + ((size_t)(u.pm * 8 + u.pn) * 256 + tid_), (p4[0] + p4[1]) + (p4[2] + p4[3]), __ATOMIC_RELAXED, __HIP_MEMORY_SCOPE_AGENT);
            }
            asm volatile("s_waitcnt vmcnt(0)" ::: "memory"); __builtin_amdgcn_s_barrier(); asm volatile("" ::: "memory");
            if (tid_ == 0) {
                __hip_atomic_fetch_add(cnt, 1u, __ATOMIC_RELAXED, __HIP_MEMORY_SCOPE_AGENT);
                unsigned spin = 0;
                while (__hip_atomic_load(cnt, __ATOMIC_RELAXED, __HIP_MEMORY_SCOPE_AGENT) < 8u && ++spin < (1u << 24)) __builtin_amdgcn_s_sleep(2);
                __builtin_amdgcn_fence(__ATOMIC_ACQUIRE, "agent");
                asm volatile("s_waitcnt vmcnt(0)" ::: "memory");
            }
            __builtin_amdgcn_s_barrier(); asm volatile("" ::: "memory");
            if (tid_ < 256) {
                float t = 0.f;
#pragma unroll
                for (int j = 0; j < 8; ++j) t += __hip_atomic_load(xs + ((size_t)(u.pm * 8 + j) * 256 + tid_), __ATOMIC_RELAXED, __HIP_MEMORY_SCOPE_AGENT);
                R[tid_] = 1.0f / sqrtf(t * (1.0f / 2048.0f) + EPS);
            }
            asm volatile("s_waitcnt lgkmcnt(0)" ::: "memory"); __builtin_amdgcn_s_barrier(); asm volatile("" ::: "memory");
            f32x4 g4[2][2];
#pragma unroll
            for (int bj = 0; bj < 2; ++bj) { g4[bj][0] = *(const f32x4*)(fg + u.pn * 256 + cl0 + bj * 128); g4[bj][1] = *(const f32x4*)(fg + u.pn * 256 + cl0 + bj * 128 + 4); }
#pragma unroll
            for (int ai = 0; ai < 2; ++ai)
#pragma unroll
                for (int m = 0; m < 4; ++m) {
                    const int rl = wr * 64 + ai * 128 + m * 16 + fr; const float rstd = R[rl];
#pragma unroll
                    for (int bj = 0; bj < 2; ++bj) {
                        const size_t off = (size_t)(u.pm * 256 + rl) * 2048 + u.pn * 256 + cl0 + bj * 128;
                        *(f32x4*)(out + off) = a[ai][bj][m][0] * rstd * g4[bj][0];
                        *(f32x4*)(out + off + 4) = a[ai][bj][m][1] * rstd * g4[bj][1];
                    }
                }
            asm volatile("s_waitcnt lgkmcnt(0)" ::: "memory"); __builtin_amdgcn_s_barrier(); asm volatile("" ::: "memory");
        } else {
#pragma unroll
            for (int ai = 0; ai < 2; ++ai)
#pragma unroll
                for (int m = 0; m < 4; ++m) {
                    const int row = row0 + ai * 128 + m * 16;
#pragma unroll
                    for (int bj = 0; bj < 2; ++bj) {
                        const size_t off = (size_t)row * 2048 + u.pn * 256 + cl0 + bj * 128;
                        const f32x4 x0 = *(const f32x4*)(x + off), x1 = *(const f32x4*)(x + off + 4);
                        *(f32x4*)(out + off) = x0 + acc[ai][bj][m][0];
                        *(f32x4*)(out + off + 4) = x1 + acc[ai][bj][m][1];
                    }
                    asm volatile("" ::: "memory");
                }
        }
    }
};

enum { MAT_IN = 0, MAT_Q = 1, MAT_KV = 2, MAT_ID = 3 };
__device__ __forceinline__ int map_col(int mat, int n) {
    if (mat == MAT_IN) {
        if (n < 5120) return n;
        if (n < 6144) return 5128 + (n - 5120);
        if (n < 7168) return 6216 + (n - 6144);
        if (n < 8192) return 7240 + (n - 7168);
        if (n < 9216) return 8264 + (n - 8192);
        if (n < 15360) return 9288 + (n - 9216);
        const int j = n - 15360;
        if (j < 64) return 6152 + (j >> 1) + ((j & 1) ? 32 : 0);
        if (j < 68) return 5120 + (j - 64);
        if (j < 72) return 5124 + (j - 68);
        return -1;
    }
    if (mat == MAT_Q) {
        if (n < 1024) { const int h = n >> 7, d = n & 127; return h * 192 + d; }
        const int j = n - 1024, h = j >> 6, r = j & 63; return h * 192 + 128 + (r >> 1) + ((r & 1) ? 32 : 0);
    }
    if (mat == MAT_KV) {
        if (n < 1024) { const int h = n >> 7, d = n & 127; return h * 256 + d; }
        const int j = n - 1024, h = j >> 7, d = j & 127; return h * 256 + 128 + d;
    }
    return n;
}
__device__ __forceinline__ void transpose_item(const float* W, int K, int Nsrc, bf16_t* WT, int mat, const float* gain, LAS float* scr, int item, int nblk, int lane) {
    const int kb = item / nblk, nb = item % nblk, k0 = 64 * kb, n0 = 32 * nb;
    const int src = map_col(mat, n0 + (lane & 31));
    float v[32];
#pragma unroll
    for (int i = 0; i < 32; ++i) { const int kk = 2 * i + (lane >> 5); v[i] = (src >= 0) ? __builtin_nontemporal_load(W + (size_t)(k0 + kk) * Nsrc + src) : 0.f; }
#pragma unroll
    for (int i = 0; i < 32; ++i) { const int kk = 2 * i + (lane >> 5); float t = v[i]; if (gain) t *= gain[k0 + kk]; scr[kk * 33 + (lane & 31)] = t; }
    LDS_WAIT(); asm volatile("" ::: "memory");
    const int c = lane & 7;
#pragma unroll
    for (int j = 0; j < 4; ++j) {
        const int n = (lane >> 3) + 8 * j; const LAS float* s = scr + (8 * c) * 33 + n;
        u32x4 o; o.x = pk2(s[0 * 33], s[1 * 33]); o.y = pk2(s[2 * 33], s[3 * 33]); o.z = pk2(s[4 * 33], s[5 * 33]); o.w = pk2(s[6 * 33], s[7 * 33]);
        *(u32x4*)(WT + (size_t)(n0 + n) * K + k0 + 8 * c) = o;
    }
    LDS_WAIT(); asm volatile("" ::: "memory");
}
__device__ __forceinline__ void rms_row_to_bf16(const float* xrow, const float* gain, bf16_t* orow, int lane) {
    const f32x4* xr = (const f32x4*)xrow + lane;
    f32x4 v[8]; float s = 0.f;
#pragma unroll
    for (int j = 0; j < 8; ++j) { v[j] = __builtin_nontemporal_load(xr + 64 * j); s += (v[j][0] * v[j][0] + v[j][1] * v[j][1]) + (v[j][2] * v[j][2] + v[j][3] * v[j][3]); }
    const float rstd = 1.0f / sqrtf(wave_sum(s) * (1.0f / 2048.0f) + EPS);
    const f32x4* gr = (const f32x4*)gain + lane;
    u32x2* o8 = (u32x2*)orow + lane;
#pragma unroll
    for (int j = 0; j < 8; ++j) { const f32x4 g = gr[64 * j]; u32x2 w; w.x = pk2(v[j][0] * rstd * g[0], v[j][1] * rstd * g[1]); w.y = pk2(v[j][2] * rstd * g[2], v[j][3] * rstd * g[3]); o8[64 * j] = w; }
}

template <int NR>
__device__ __forceinline__ void rms_rows_to_bf16(const float* x, size_t row0, size_t rstride, const float* gain, bf16_t* o, int lane) {
    f32x4 v[NR][8];
#pragma unroll
    for (int r = 0; r < NR; ++r)
#pragma unroll
        for (int j = 0; j < 8; ++j) v[r][j] = __builtin_nontemporal_load((const f32x4*)(x + (row0 + r * rstride) * DM) + lane + 64 * j);
    float sq[NR];
#pragma unroll
    for (int r = 0; r < NR; ++r) { sq[r] = 0.f;
#pragma unroll
        for (int j = 0; j < 8; ++j) sq[r] += (v[r][j][0] * v[r][j][0] + v[r][j][1] * v[r][j][1]) + (v[r][j][2] * v[r][j][2] + v[r][j][3] * v[r][j][3]); }
#pragma unroll
    for (int o2 = 1; o2 < 64; o2 <<= 1)
#pragma unroll
        for (int r = 0; r < NR; ++r) sq[r] += __shfl_xor(sq[r], o2);
    const f32x4* gr = (const f32x4*)gain + lane;
#pragma unroll
    for (int r = 0; r < NR; ++r) {
        const float rs = 1.0f / sqrtf(sq[r] * (1.0f / 2048.0f) + EPS);
        u32x2* op = (u32x2*)(o + (row0 + r * rstride) * DM) + lane;
#pragma unroll
        for (int j = 0; j < 8; ++j) { const f32x4 g = gr[64 * j]; u32x2 w; w.x = pk2(v[r][j][0] * rs * g[0], v[r][j][1] * rs * g[1]); w.y = pk2(v[r][j][2] * rs * g[2], v[r][j][3] * rs * g[3]); op[64 * j] = w; }
    }
}

template <int W1, int W2, int DV, bool CAUSAL, int NQ>
__device__ __forceinline__ void attn_unit(LAS unsigned char* lds,
        const bf16_t* Q1, int ldq1, const bf16_t* Q2, int ldq2,
        const bf16_t* K1, int ldk1, const bf16_t* K2, int ldk2,
        const bf16_t* V, int ldv, const bf16_t* Z, int ldz, bf16_t* O, int ldo,
        int nkt, int qb, float scale_log2) {
    constexpr int DQK = W1 + W2, NKS = DQK / 32, KSTR = DQK + 8, VROWB = DV * 2, NDT = DV / 16;
    constexpr int NK1 = W1 / 64, NV = DV / 64;
    constexpr int TILE_B = 64 * KSTR * 2 + 64 * VROWB;
    const int tid = opaque_tid(), lane = tid & 63, wid = tid >> 6, r16 = lane & 15, quad = lane >> 4;
    bf16x8 qf[NQ][NKS];
#pragma unroll
    for (int q = 0; q < NQ; ++q) {
        const bf16_t* q1 = Q1 + (size_t)(16 * NQ * wid + 16 * q + r16) * ldq1;
#pragma unroll
        for (int ks = 0; ks < W1 / 32; ++ks) qf[q][ks] = *(const bf16x8*)(q1 + 32 * ks + 8 * quad);
        if constexpr (W2 > 0) {
            const bf16_t* q2 = Q2 + (size_t)(16 * NQ * wid + 16 * q + r16) * ldq2;
#pragma unroll
            for (int ks = 0; ks < W2 / 32; ++ks) qf[q][W1 / 32 + ks] = *(const bf16x8*)(q2 + 32 * ks + 8 * quad);
        }
    }
    u32x4 pk1[NK1], pk2r, pv[NV];
    auto gload = [&](int kt) {
#pragma unroll
        for (int i = 0; i < NK1; ++i) { const int id = tid + 512 * i, row = id / (W1 / 8), cc = id % (W1 / 8); pk1[i] = *(const u32x4*)(K1 + (size_t)(64 * kt + row) * ldk1 + cc * 8); }
        if constexpr (W2 > 0) { const int row = tid >> 3, cc = tid & 7; pk2r = *(const u32x4*)(K2 + (size_t)(64 * kt + row) * ldk2 + cc * 8); }
#pragma unroll
        for (int i = 0; i < NV; ++i) { const int id = tid + 512 * i, row = id / (DV / 8), cc = id % (DV / 8); pv[i] = *(const u32x4*)(V + (size_t)(64 * kt + row) * ldv + cc * 8); }
    };
    auto lstore = [&](int bufi) {
        LAS bf16_t* Ks = (LAS bf16_t*)(lds + bufi * TILE_B); LAS unsigned char* Vi = lds + bufi * TILE_B + 64 * KSTR * 2;
#pragma unroll
        for (int i = 0; i < NK1; ++i) { const int id = tid + 512 * i, row = id / (W1 / 8), cc = id % (W1 / 8); *(LAS u32x4*)(Ks + row * KSTR + cc * 8) = pk1[i]; }
        if constexpr (W2 > 0) { const int row = tid >> 3, cc = tid & 7; *(LAS u32x4*)(Ks + row * KSTR + W1 + cc * 8) = pk2r; }
#pragma unroll
        for (int i = 0; i < NV; ++i) {
            const int id = tid + 512 * i, row = id / (DV / 8), cc = id % (DV / 8);
            *(LAS u32x4*)(Vi + VROWB * row + 16 * (cc ^ (((row & 3) << 2) | ((row >> 2) & 3)))) = pv[i];
        }
    };
    f32x4 o[NQ][NDT];
    float m_run[NQ], l_run[NQ];
#pragma unroll
    for (int q = 0; q < NQ; ++q) { m_run[q] = -1e30f; l_run[q] = 0.f;
#pragma unroll
        for (int d = 0; d < NDT; ++d) o[q][d] = (f32x4){0.f, 0.f, 0.f, 0.f}; }
    const int qpos0 = 128 * NQ * qb + 16 * NQ * wid + r16;
    __syncthreads();
    gload(0); lstore(0); if (nkt > 1) gload(1); __syncthreads();
    const int kdiag = CAUSAL ? (nkt - 2 * NQ) : nkt;
    for (int kt = 0; kt < nkt; ++kt) {
        const LAS bf16_t* Ks = (const LAS bf16_t*)(lds + (kt & 1) * TILE_B); const unsigned vbase = (unsigned)(size_t)(lds + (kt & 1) * TILE_B + 64 * KSTR * 2);
        if (kt + 1 < nkt) { lstore((kt + 1) & 1); if (kt + 2 < nkt) gload(kt + 2); }
        f32x4 s[NQ][4];
#pragma unroll
        for (int st = 0; st < 4; ++st) {
#pragma unroll
            for (int q = 0; q < NQ; ++q) s[q][st] = (f32x4){0.f, 0.f, 0.f, 0.f};
#pragma unroll
            for (int ks = 0; ks < NKS; ++ks) {
                const bf16x8 a = *(const LAS bf16x8*)(Ks + (16 * st + r16) * KSTR + 32 * ks + 8 * quad);
#pragma unroll
                for (int q = 0; q < NQ; ++q) s[q][st] = MFMA16(a, qf[q][ks], s[q][st]);
            }
        }
        bf16x8 pf[NQ][2];
#pragma unroll
        for (int q = 0; q < NQ; ++q) {
            if (CAUSAL && kt >= kdiag) {
#pragma unroll
                for (int st = 0; st < 4; ++st)
#pragma unroll
                    for (int j = 0; j < 4; ++j) { const int key = 64 * kt + 16 * st + 4 * quad + j; if (key > qpos0 + 16 * q) s[q][st][j] = -1e30f; }
            }
            float mx = fmaxf(fmaxf(fmaxf(s[q][0][0], s[q][0][1]), fmaxf(s[q][0][2], s[q][0][3])), fmaxf(fmaxf(s[q][1][0], s[q][1][1]), fmaxf(s[q][1][2], s[q][1][3])));
            mx = fmaxf(mx, fmaxf(fmaxf(fmaxf(s[q][2][0], s[q][2][1]), fmaxf(s[q][2][2], s[q][2][3])), fmaxf(fmaxf(s[q][3][0], s[q][3][1]), fmaxf(s[q][3][2], s[q][3][3]))));
            mx = fmaxf(mx, __shfl_xor(mx, 16)); mx = fmaxf(mx, __shfl_xor(mx, 32));
            const float m_new = (mx > m_run[q] + 5.0f / scale_log2) ? mx : m_run[q];
            const float nms = -m_new * scale_log2;
            float rs = 0.f;
#pragma unroll
            for (int st = 0; st < 4; ++st)
#pragma unroll
                for (int j = 0; j < 4; ++j) { const float p = __builtin_amdgcn_exp2f(__builtin_fmaf(s[q][st][j], scale_log2, nms)); s[q][st][j] = p; rs += p; }
            rs += __shfl_xor(rs, 16); rs += __shfl_xor(rs, 32);
            if (__builtin_amdgcn_ballot_w64(m_new != m_run[q]) != 0ull) {
                const float alpha = __builtin_amdgcn_exp2f((m_run[q] - m_new) * scale_log2);
                l_run[q] *= alpha;
#pragma unroll
                for (int d = 0; d < NDT; ++d) o[q][d] = o[q][d] * alpha;
            }
            l_run[q] += rs; m_run[q] = m_new;
#pragma unroll
            for (int kk = 0; kk < 2; ++kk) {
                u32x4 w; w.x = pk2(s[q][2 * kk][0], s[q][2 * kk][1]); w.y = pk2(s[q][2 * kk][2], s[q][2 * kk][3]); w.z = pk2(s[q][2 * kk + 1][0], s[q][2 * kk + 1][1]); w.w = pk2(s[q][2 * kk + 1][2], s[q][2 * kk + 1][3]);
                pf[q][kk] = __builtin_bit_cast(bf16x8, w);
            }
        }
        {
            const int g_ = quad, q_ = r16 >> 2, p_ = lane & 3;
            unsigned vlane = vbase + VROWB * (4 * g_ + q_) + 8 * (p_ & 1); asm volatile("" : "+v"(vlane));
            const int sw_ = (q_ << 2) | g_, ph_ = p_ >> 1;
            s16x4 vb[2][4];
#define TR_ISSUE(c_, bf_) do { const unsigned ad_ = vlane + 16u * (unsigned)((2 * (c_) + ph_) ^ sw_); \
                asm volatile("ds_read_b64_tr_b16 %0, %4\n\tds_read_b64_tr_b16 %1, %4 offset:%5\n\tds_read_b64_tr_b16 %2, %4 offset:%6\n\tds_read_b64_tr_b16 %3, %4 offset:%7" \
                    : "=&v"(vb[bf_][0]), "=&v"(vb[bf_][1]), "=&v"(vb[bf_][2]), "=&v"(vb[bf_][3]) : "v"(ad_), "n"(16 * VROWB), "n"(32 * VROWB), "n"(48 * VROWB) : "memory"); } while (0)
            TR_ISSUE(0, 0);
#pragma unroll
            for (int d = 0; d < NDT; ++d) {
                const int cur = d & 1;
                if (d + 1 < NDT) {
                    TR_ISSUE(d + 1, (d + 1) & 1);
                    asm volatile("s_waitcnt lgkmcnt(4)" : "+v"(vb[cur][0]), "+v"(vb[cur][1]), "+v"(vb[cur][2]), "+v"(vb[cur][3]) :: "memory");
                } else {
                    asm volatile("s_waitcnt lgkmcnt(0)" : "+v"(vb[cur][0]), "+v"(vb[cur][1]), "+v"(vb[cur][2]), "+v"(vb[cur][3]) :: "memory");
                }
                const bf16x8 a0 = __builtin_shufflevector(vb[cur][0], vb[cur][1], 0, 1, 2, 3, 4, 5, 6, 7);
                const bf16x8 a1 = __builtin_shufflevector(vb[cur][2], vb[cur][3], 0, 1, 2, 3, 4, 5, 6, 7);
#pragma unroll
                for (int q = 0; q < NQ; ++q) { o[q][d] = MFMA16(a0, pf[q][0], o[q][d]); o[q][d] = MFMA16(a1, pf[q][1], o[q][d]); }
            }
#undef TR_ISSUE
        }
        __syncthreads();
    }
#pragma unroll
    for (int q = 0; q < NQ; ++q) {
        const float linv = 1.0f / l_run[q];
        const bf16_t* zr = Z + (size_t)(16 * NQ * wid + 16 * q + r16) * ldz; bf16_t* orow = O + (size_t)(16 * NQ * wid + 16 * q + r16) * ldo;
#pragma unroll
        for (int d = 0; d < NDT; ++d) {
            const u32x2 z = *(const u32x2*)(zr + 16 * d + 4 * quad);
            u32x2 w; w.x = pk2(o[q][d][0] * linv * siluf_(bflo(z.x)), o[q][d][1] * linv * siluf_(bfhi(z.x))); w.y = pk2(o[q][d][2] * linv * siluf_(bflo(z.y)), o[q][d][3] * linv * siluf_(bfhi(z.y)));
            *(u32x2*)(orow + 16 * d + 4 * quad) = w;
        }
    }
}

__device__ __forceinline__ void conv_item(bf16_t* QK, const bf16_t* HALO, const float* conv_w, const float* conv_b, int hc, int cg) {
    const int chan = cg * 8; const float osc = (chan >= 1024) ? 0.0625f : 1.0f;
    float cw[4][8], cb[8];
#pragma unroll
    for (int j = 0; j < 4; ++j) { const f32x4 a = *(const f32x4*)(conv_w + j * 2048 + chan), c2 = *(const f32x4*)(conv_w + j * 2048 + chan + 4);
        cw[j][0] = a[0]; cw[j][1] = a[1]; cw[j][2] = a[2]; cw[j][3] = a[3]; cw[j][4] = c2[0]; cw[j][5] = c2[1]; cw[j][6] = c2[2]; cw[j][7] = c2[3]; }
    { const f32x4 a = *(const f32x4*)(conv_b + chan), c2 = *(const f32x4*)(conv_b + chan + 4); cb[0] = a[0]; cb[1] = a[1]; cb[2] = a[2]; cb[3] = a[3]; cb[4] = c2[0]; cb[5] = c2[1]; cb[6] = c2[2]; cb[7] = c2[3]; }
    float xp[3][8];
    if ((hc & 63) == 0) {
#pragma unroll
        for (int i = 0; i < 3; ++i)
#pragma unroll
            for (int ch = 0; ch < 8; ++ch) xp[i][ch] = 0.f;
    } else {
#pragma unroll
        for (int i = 0; i < 3; ++i) { const u32x4 xv = *(const u32x4*)(HALO + ((size_t)(hc - 1) * 3 + i) * 2048 + chan);
            xp[i][0] = bflo(xv.x); xp[i][1] = bfhi(xv.x); xp[i][2] = bflo(xv.y); xp[i][3] = bfhi(xv.y); xp[i][4] = bflo(xv.z); xp[i][5] = bfhi(xv.z); xp[i][6] = bflo(xv.w); xp[i][7] = bfhi(xv.w); }
    }
    bf16_t* base = QK + (size_t)hc * 32 * 2048 + chan;
    for (int sb = 0; sb < 4; ++sb) {
        u32x4 xr[8];
#pragma unroll
        for (int r = 0; r < 8; ++r) xr[r] = *(const u32x4*)(base + (size_t)(sb * 8 + r) * 2048);
#pragma unroll
        for (int r = 0; r < 8; ++r) {
            const u32x4 xv = xr[r];
            const float xf[8] = {bflo(xv.x), bfhi(xv.x), bflo(xv.y), bfhi(xv.y), bflo(xv.z), bfhi(xv.z), bflo(xv.w), bfhi(xv.w)};
            float y[8];
#pragma unroll
            for (int ch = 0; ch < 8; ++ch) {
                y[ch] = cb[ch] + cw[0][ch] * xp[0][ch] + cw[1][ch] * xp[1][ch] + cw[2][ch] * xp[2][ch] + cw[3][ch] * xf[ch];
                xp[0][ch] = xp[1][ch]; xp[1][ch] = xp[2][ch]; xp[2][ch] = xf[ch];
                y[ch] = siluf_(y[ch]) * osc;
            }
            u32x4 w; w.x = pk2(y[0], y[1]); w.y = pk2(y[2], y[3]); w.z = pk2(y[4], y[5]); w.w = pk2(y[6], y[7]);
            *(u32x4*)(base + (size_t)(sb * 8 + r) * 2048) = w;
        }
    }
}

constexpr int ML_QS = 0, ML_KS = 33792, ML_WKT = 67584, ML_VT0 = 104448, ML_VT1 = 109200, ML_CB0 = 113808, ML_CB1 = 131232, ML_SC = 148128;
__device__ __forceinline__ void mlstm_unit(LAS unsigned char* lds, int b, int h, int vp, const bf16_t* QK, const bf16_t* MV, bf16_t* HR, const bf16_t* MISC, float bi, float bfg) {
    LAS bf16_t* Qs = (LAS bf16_t*)(lds + ML_QS);
    LAS bf16_t* Ks = (LAS bf16_t*)(lds + ML_KS);
    LAS bf16_t* wKt = (LAS bf16_t*)(lds + ML_WKT);
    LAS bf16_t* Vt0 = (LAS bf16_t*)(lds + ML_VT0);
    LAS bf16_t* Vt1 = (LAS bf16_t*)(lds + ML_VT1);
    LAS bf16_t* Cb0 = (LAS bf16_t*)(lds + ML_CB0);
    LAS bf16_t* Cb1 = (LAS bf16_t*)(lds + ML_CB1);
    LAS float* scb = (LAS float*)(lds + ML_SC);
    const int tid = opaque_tid(), lane = tid & 63, wid = tid >> 6, r16 = lane & 15, quad = lane >> 4;
    __syncthreads();
    for (int i = tid; i < (ML_SC - ML_CB0) / 4; i += NTHR) ((LAS unsigned*)Cb0)[i] = 0u;
    if (tid < 72) Vt0[32 * 72 + tid] = (bf16_t)0x3F80;
    f32x4 cacc[2][3], cacc1[2][2];
#pragma unroll
    for (int a = 0; a < 2; ++a)
#pragma unroll
        for (int n = 0; n < 3; ++n) { cacc[a][n] = (f32x4){0.f, 0.f, 0.f, 0.f}; if (n < 2) cacc1[a][n] = (f32x4){0.f, 0.f, 0.f, 0.f}; }
    float m_state = 0.f;
    const int role = __builtin_amdgcn_readfirstlane(wid >> 2), cgl = lane & 31, rg = (wid & 3) * 2 + (lane >> 5);
    const int chan = role * 1024 + h * 256 + cgl * 8;
    const int tt = wid & 3, vh = wid >> 2;
    const size_t rowb = (size_t)b * SEQ;
    u32x4 xr[8], vreg; bf16_t graw_i = 0, graw_f = 0;
#define ML_LOAD(c_) do { const size_t r0_ = rowb + 64 * (c_); \
        _Pragma("unroll") for (int i = 0; i < 8; ++i) xr[i] = *(const u32x4*)(QK + (r0_ + rg * 8 + i) * 2048 + chan); \
        vreg = *(const u32x4*)(MV + (r0_ + (tid >> 3)) * 1024 + h * 256 + vp * 64 + (tid & 7) * 8); \
        if (wid == 0) { const bf16_t* mr = MISC + (r0_ + lane) * 256; graw_i = mr[64 + h]; graw_f = mr[68 + h]; } } while (0)
#define ML_GATES(s_) do { LAS float* sc_ = scb + 384 * (s_); \
        const float ic = bf2f(graw_i) + bi, fp = bf2f(graw_f) + bfg; \
        const float fc = fminf(fp, 0.f) - __logf(1.0f + __expf(-fabsf(fp))); \
        float bt = fc; \
        _Pragma("unroll") for (int o = 1; o < 64; o <<= 1) { const float t = __shfl_up(bt, o); if (lane >= o) bt += t; } \
        const float uu = ic - bt; float pm = uu; \
        _Pragma("unroll") for (int o = 1; o < 64; o <<= 1) { const float t = __shfl_up(pm, o); if (lane >= o) pm = fmaxf(pm, t); } \
        const float g = __shfl(bt, 63), pm63 = __shfl(pm, 63); \
        const float mx = fmaxf(m_state, pm), mx63 = fmaxf(m_state, pm63); \
        sc_[lane] = uu; sc_[64 + lane] = mx; sc_[128 + lane] = __expf(m_state - mx); sc_[192 + lane] = __expf(-(bt + mx)); sc_[256 + lane] = __expf(uu - mx63); \
        if (lane == 0) sc_[320] = __expf(m_state - mx63); \
        m_state = g + mx63; } while (0)
    ML_LOAD(0);
    if (wid == 0) ML_GATES(0);
    __syncthreads();
    for (int c = 0; c < 32; ++c) {
        LAS float* sc = scb + 384 * (c & 1);
        {
#pragma unroll
            for (int r = 0; r < 8; ++r) *(LAS u32x4*)((role == 0 ? Qs : Ks) + (rg * 8 + r) * 264 + cgl * 8) = xr[r];
            if (role == 1) {
#pragma unroll
                for (int rp = 0; rp < 4; ++rp) {
                    const int t0 = rg * 8 + 2 * rp;
                    const float w0 = sc[256 + t0], w1 = sc[256 + t0 + 1];
                    const u32x4 xa = xr[2 * rp], xb = xr[2 * rp + 1];
                    const float fa[8] = {bflo(xa.x), bfhi(xa.x), bflo(xa.y), bfhi(xa.y), bflo(xa.z), bfhi(xa.z), bflo(xa.w), bfhi(xa.w)};
                    const float fb[8] = {bflo(xb.x), bfhi(xb.x), bflo(xb.y), bfhi(xb.y), bflo(xb.z), bfhi(xb.z), bflo(xb.w), bfhi(xb.w)};
#pragma unroll
                    for (int ch = 0; ch < 8; ++ch) *(LAS unsigned*)(wKt + (cgl * 8 + ch) * 72 + (((t0 >> 3) ^ (cgl & 7)) << 3) + (t0 & 7)) = pk2(fa[ch] * w0, fb[ch] * w1);
                }
            }
            {
                const int s = tid >> 3, cc = tid & 3; LAS bf16_t* Vt = (tid & 4) ? Vt1 : Vt0;
                const unsigned w[4] = {vreg.x, vreg.y, vreg.z, vreg.w};
#pragma unroll
                for (int j = 0; j < 4; ++j) { const int sc2 = (((s >> 2) ^ (4 * cc)) << 2) + (s & 3); Vt[(cc * 8 + 2 * j) * 72 + sc2] = (bf16_t)(w[j] & 0xffffu); Vt[(cc * 8 + 2 * j + 1) * 72 + sc2] = (bf16_t)(w[j] >> 16); }
            }
        }
        __syncthreads();
        if (c + 1 < 32) ML_LOAD(c + 1);
        const float decay = sc[320];
        {
            const LAS bf16_t* qrow = Qs + (16 * tt + r16) * 264 + 8 * quad;
#define QF(ks_) (*(const LAS bf16x8*)(qrow + 32 * (ks_)))
            const int tpos = 16 * tt + r16;
            const float mxt = sc[64 + tpos];
            f32x4 p[4];
#pragma unroll
            for (int st = 0; st < 4; ++st) {
                p[st] = (f32x4){0.f, 0.f, 0.f, 0.f};
                if (st <= tt) {
#pragma unroll
                    for (int ks = 0; ks < 8; ++ks) { const bf16x8 a = *(const LAS bf16x8*)(Ks + (16 * st + r16) * 264 + 32 * ks + 8 * quad); p[st] = MFMA16(a, QF(ks), p[st]); }
                    const f32x4 uu = *(const LAS f32x4*)(sc + 16 * st + 4 * quad);
#pragma unroll
                    for (int j = 0; j < 4; ++j) { const int sp = 16 * st + 4 * quad + j; p[st][j] = (sp <= tpos) ? p[st][j] * __expf(uu[j] - mxt) : 0.f; }
                }
            }
            __builtin_amdgcn_sched_barrier(0);
            bf16x8 pf[2];
#pragma unroll
            for (int kk = 0; kk < 2; ++kk) {
                u32x4 w; w.x = pk2(p[2 * kk][0], p[2 * kk][1]); w.y = pk2(p[2 * kk][2], p[2 * kk][3]); w.z = pk2(p[2 * kk + 1][0], p[2 * kk + 1][1]); w.w = pk2(p[2 * kk + 1][2], p[2 * kk + 1][3]);
                pf[kk] = __builtin_bit_cast(bf16x8, w);
            }
            __builtin_amdgcn_sched_barrier(0);
            f32x4 ia = (f32x4){0.f, 0.f, 0.f, 0.f}, ib = ia, na = ia, nb = ia, ia1 = ia, na1 = ia;
#pragma unroll
            for (int ks = 0; ks < 8; ++ks) {
                const bf16x8 a0 = *(const LAS bf16x8*)(Cb0 + (16 * vh + r16) * 264 + 32 * ks + 8 * quad);
                const bf16x8 a1 = *(const LAS bf16x8*)(Cb0 + (32 + r16) * 264 + 32 * ks + 8 * quad);
                const bf16x8 a2 = *(const LAS bf16x8*)(Cb1 + (16 * vh + r16) * 264 + 32 * ks + 8 * quad);
                const bf16x8 qv = QF(ks); ia = MFMA16(a0, qv, ia); ib = MFMA16(a1, qv, ib); ia1 = MFMA16(a2, qv, ia1);
            }
#pragma unroll
            for (int kk = 0; kk < 2; ++kk) {
                const int vsw = 4 * (2 * vh + (r16 >> 3));
                const s16x4 lo0 = *(const LAS s16x4*)(Vt0 + (16 * vh + r16) * 72 + (((8 * kk + quad) ^ vsw) << 2)), hi0 = *(const LAS s16x4*)(Vt0 + (16 * vh + r16) * 72 + (((8 * kk + 4 + quad) ^ vsw) << 2));
                const s16x4 lo1 = *(const LAS s16x4*)(Vt0 + (32 + r16) * 72 + 32 * kk + 4 * quad), hi1 = *(const LAS s16x4*)(Vt0 + (32 + r16) * 72 + 32 * kk + 16 + 4 * quad);
                const s16x4 lo2 = *(const LAS s16x4*)(Vt1 + (16 * vh + r16) * 72 + (((8 * kk + quad) ^ vsw) << 2)), hi2 = *(const LAS s16x4*)(Vt1 + (16 * vh + r16) * 72 + (((8 * kk + 4 + quad) ^ vsw) << 2));
                na = MFMA16(__builtin_shufflevector(lo0, hi0, 0, 1, 2, 3, 4, 5, 6, 7), pf[kk], na);
                nb = MFMA16(__builtin_shufflevector(lo1, hi1, 0, 1, 2, 3, 4, 5, 6, 7), pf[kk], nb);
                na1 = MFMA16(__builtin_shufflevector(lo2, hi2, 0, 1, 2, 3, 4, 5, 6, 7), pf[kk], na1);
            }
            __builtin_amdgcn_sched_barrier(0);
            const float wi = sc[128 + tpos], en = sc[192 + tpos];
            const float denq = wi * ib[0] + nb[0];
            const float den = __shfl(denq, r16);
            const float dinv = 1.0f / fmaxf(fabsf(den), en);
            u32x2 w; w.x = pk2((wi * ia[0] + na[0]) * dinv, (wi * ia[1] + na[1]) * dinv); w.y = pk2((wi * ia[2] + na[2]) * dinv, (wi * ia[3] + na[3]) * dinv);
            *(u32x2*)(HR + ((size_t)(h * 8 + 2 * vp) * 2048 + 64 * c + tpos) * 32 + 16 * vh + 4 * quad) = w;
            w.x = pk2((wi * ia1[0] + na1[0]) * dinv, (wi * ia1[1] + na1[1]) * dinv); w.y = pk2((wi * ia1[2] + na1[2]) * dinv, (wi * ia1[3] + na1[3]) * dinv);
            *(u32x2*)(HR + ((size_t)(h * 8 + 2 * vp + 1) * 2048 + 64 * c + tpos) * 32 + 16 * vh + 4 * quad) = w;
        }
        asm volatile("s_waitcnt lgkmcnt(0)" ::: "memory"); __builtin_amdgcn_s_barrier(); asm volatile("" ::: "memory");
        {
#pragma unroll
            for (int a = 0; a < 2; ++a) {
                const int mt = 2 * wid + a;
                bf16x8 af[2];
#pragma unroll
                for (int kk = 0; kk < 2; ++kk) af[kk] = *(const LAS bf16x8*)(wKt + (16 * mt + r16) * 72 + (((4 * kk + quad) ^ ((2 * mt + (r16 >> 3)) & 7)) << 3));
#pragma unroll
                for (int n = 0; n < 3; ++n) {
                    f32x4 acc = cacc[a][n] * decay;
#pragma unroll
                    for (int kk = 0; kk < 2; ++kk) {
                        const bf16x8 bfr = *(const LAS bf16x8*)(Vt0 + (16 * n + r16) * 72 + ((((8 * kk + 2 * quad) ^ ((n < 2) ? 4 * ((2 * n + (r16 >> 3)) & 3) : 0))) << 2));
                        acc = MFMA16(af[kk], bfr, acc);
                    }
                    cacc[a][n] = acc;
                    u32x2 w; w.x = pk2(acc[0], acc[1]); w.y = pk2(acc[2], acc[3]);
                    if (n < 2 || r16 == 0) *(LAS u32x2*)(Cb0 + (16 * n + r16) * 264 + 16 * mt + 4 * quad) = w;
                }
#pragma unroll
                for (int n = 0; n < 2; ++n) {
                    f32x4 acc = cacc1[a][n] * decay;
#pragma unroll
                    for (int kk = 0; kk < 2; ++kk) {
                        const bf16x8 bfr = *(const LAS bf16x8*)(Vt1 + (16 * n + r16) * 72 + ((((8 * kk + 2 * quad) ^ (4 * ((2 * n + (r16 >> 3)) & 3)))) << 2));
                        acc = MFMA16(af[kk], bfr, acc);
                    }
                    cacc1[a][n] = acc;
                    u32x2 w; w.x = pk2(acc[0], acc[1]); w.y = pk2(acc[2], acc[3]);
                    *(LAS u32x2*)(Cb1 + (16 * n + r16) * 264 + 16 * mt + 4 * quad) = w;
                }
            }
            if (wid == 0 && c + 1 < 32) ML_GATES((c + 1) & 1);
        }
        __syncthreads();
    }
#undef QF
#undef ML_LOAD
#undef ML_GATES
}

__device__ __forceinline__ size_t hraw_off(int b) { return (b < 3) ? (489 * MiB + (size_t)b * 4 * MiB) : (b < 5 ? (504 * MiB + (size_t)(b - 3) * 4 * MiB) : (69 * MiB + (size_t)(b - 5) * 4 * MiB)); }
#define XB_TMO      128
#define XB_XCNT(j)  (256  + 64 * (j))
#define XB_XSUB(j)  (1280 + 64 * (j))
#define XB_XGEN(j)  (2304 + 64 * (j))
#define XB_TOP      3328
#define XB_TOPGEN   3392
#define XCD_BAR_WORDS 3456
#define XB_SPIN_CAP (1u << 18)

__device__ __forceinline__ unsigned xb_ld(unsigned* p)              { return __hip_atomic_load(p, __ATOMIC_RELAXED, __HIP_MEMORY_SCOPE_AGENT); }
__device__ __forceinline__ unsigned xb_add(unsigned* p, unsigned v) { return __hip_atomic_fetch_add(p, v, __ATOMIC_RELAXED, __HIP_MEMORY_SCOPE_AGENT); }
__device__ __forceinline__ unsigned xb_xcc_id() { return (unsigned)__builtin_amdgcn_s_getreg((3 << 11) | 20) & 0xFu; }
#define XB_SPIN(cond, bar) do { unsigned _sp = 0; while (cond) { __builtin_amdgcn_s_sleep(1); \
    if ((++_sp & 255u) == 0u) { if (xb_ld(&(bar)[XB_TMO])) break; if (_sp > XB_SPIN_CAP) { atomicAdd(&(bar)[XB_TMO], 1u); break; } } } } while (0)

struct XcdBarrier {
    unsigned* bar; unsigned x;
    volatile LAS unsigned* st;
};

__device__ __forceinline__ XcdBarrier xcd_barrier_post(unsigned* bar, volatile LAS unsigned* st) {
    XcdBarrier b; b.bar = bar; b.x = xb_xcc_id(); b.st = st;
    if (threadIdx.x == 0) (void)xb_add(&bar[XB_XCNT(b.x)], 1u);
    return b;
}
__device__ __forceinline__ void xcd_barrier_complete(unsigned* bar, unsigned x, unsigned& nloc, unsigned& nx) {
    const unsigned G = gridDim.x * gridDim.y * gridDim.z;
    unsigned sum, cnt, mine, sp = 0u;
    for (;;) {
        sum = 0u; cnt = 0u; mine = 0u;
#pragma unroll
        for (unsigned j = 0; j < 16; ++j) { const unsigned c = xb_ld(&bar[XB_XCNT(j)]); sum += c; cnt += (c > 0u) ? 1u : 0u; mine = (j == x) ? c : mine; }
        if (sum == G) break;
        __builtin_amdgcn_s_sleep(1);
        if ((++sp & 255u) == 0u) { if (xb_ld(&bar[XB_TMO])) break; if (sp > XB_SPIN_CAP) { atomicAdd(&bar[XB_TMO], 1u); break; } }
    }
    nloc = mine > 0u ? mine : 1u; nx = cnt > 0u ? cnt : 1u;
}

__device__ __forceinline__ void xcd_barrier(const XcdBarrier& b) {
    asm volatile("s_waitcnt vmcnt(0)" ::: "memory");
    __syncthreads();
    if (threadIdx.x == 0) {
        unsigned* bar = b.bar;
        __builtin_amdgcn_s_waitcnt(0);
        unsigned nloc = b.st[0], nx = b.st[1];
        if (nloc == 0u) { xcd_barrier_complete(bar, b.x, nloc, nx); b.st[0] = nloc; b.st[1] = nx; }
        const unsigned old = xb_add(&bar[XB_XSUB(b.x)], 1u);
        const unsigned gen = old / nloc;
        if (old + 1u == (gen + 1u) * nloc) {
            __builtin_amdgcn_fence(__ATOMIC_RELEASE, "agent");
            asm volatile("s_waitcnt vmcnt(0)" ::: "memory");
            const unsigned og = xb_add(&bar[XB_TOP], 1u);
            const unsigned tg = og / nx;
            if (og + 1u == (tg + 1u) * nx) xb_add(&bar[XB_TOPGEN], 1u);
            else XB_SPIN(xb_ld(&bar[XB_TOPGEN]) == tg, bar);
            __builtin_amdgcn_fence(__ATOMIC_ACQUIRE, "agent");
            xb_add(&bar[XB_XGEN(b.x)], 1u);
            asm volatile("s_waitcnt vmcnt(0)" ::: "memory");
        } else {
            XB_SPIN(xb_ld(&bar[XB_XGEN(b.x)]) == gen, bar);
            __builtin_amdgcn_fence(__ATOMIC_ACQUIRE, "agent");
            asm volatile("s_waitcnt vmcnt(0)" ::: "memory");
        }
    }
    __syncthreads();
}

__global__ void __launch_bounds__(NTHR, 2) fwd_megakernel(Args A) {
    extern __shared__ __attribute__((aligned(16))) unsigned char lds_raw[];
    LAS unsigned char* lds = (LAS unsigned char*)lds_raw;
    cg::grid_group grid = cg::this_grid();
#define GRID_SYNC() do { XcdBarrier b_ = xbar; asm volatile("" : "+s"(b_.bar)); xcd_barrier(b_); } while (0)
    const int wid = __builtin_amdgcn_readfirstlane(threadIdx.x >> 6);
    const int G = gridDim.x, bx = blockIdx.x;
    const int gw = bx * NWAVES + wid, NGW = G * NWAVES;
    unsigned char* ws = A.ws; unsigned char* dob = (unsigned char*)A.out;
    unsigned* ctl = (unsigned*)(ws + WS_CTL);
    LAS float* scr = (LAS float*)(lds + wid * 16384);
    for (int i = threadIdx.x; i < LDS_BYTES / 4; i += NTHR) ((LAS unsigned*)lds)[i] = 0u;
    __syncthreads();
    XcdBarrier xbar = xcd_barrier_post(ctl + CW_BAR, (volatile LAS unsigned*)(lds + LDS_BYTES - 64));
    grid.sync();

    {
        const int tid = opaque_tid(), lane = tid & 63;
        constexpr int I_IN = 32 * (IN_PAD / 32), I_Q = 8 * 48, I_KV = 8 * 64, I_MKV = 32 * 64;
        for (int it = gw; it < I_IN + I_Q + I_KV + I_MKV; it += NGW) {
            int r = it;
            if (r < I_IN) { transpose_item(A.w_in, 2048, IN_DIM, (bf16_t*)(ws + WS_WINT), MAT_IN, nullptr, scr, r, IN_PAD / 32, lane); continue; } r -= I_IN;
            if (r < I_Q) { transpose_item(A.w_uq, 512, 1536, (bf16_t*)(ws + WS_WQT), MAT_Q, A.cq_norm, scr, r, 48, lane); continue; } r -= I_Q;
            if (r < I_KV) { transpose_item(A.w_ukv, 512, 2048, (bf16_t*)(ws + WS_WKVT), MAT_KV, A.ckv_norm, scr, r, 64, lane); continue; } r -= I_KV;
            transpose_item(A.w_mem_kv, 2048, 2048, (bf16_t*)(ws + WS_WMKVT), MAT_ID, nullptr, scr, r, 64, lane);
        }
        for (int m = gw; m < NB * NMEM; m += NGW) rms_row_to_bf16(A.mem + (size_t)m * DM, A.mem_norm, (bf16_t*)(ws + WS_MEMN) + (size_t)m * DM, lane);
        if (MTOK % (4 * NGW) == 0) {
            for (int m = gw; m < MTOK; m += 4 * NGW) rms_rows_to_bf16<4>(A.x, (size_t)m, (size_t)NGW, A.norm, (bf16_t*)(ws + WS_HBF), lane);
        } else {
            for (int m = gw; m < MTOK; m += NGW) rms_row_to_bf16(A.x + (size_t)m * DM, A.norm, (bf16_t*)(ws + WS_HBF) + (size_t)m * DM, lane);
        }
        float* cs = (float*)(ws + WS_CS);
        for (int i = bx * NTHR + tid; i < MTOK * 32; i += G * NTHR) {
            const int tok = i >> 5, fi = i & 31;
            const float invf = exp2f(-(float)fi * (13.287712379549449f / 32.0f));
            const float ang = (float)A.pos[tok] * invf;
            const double rev = (double)ang * 0.15915494309189535;
            const float fr = (float)(rev - rint(rev));
            cs[2 * i] = __builtin_amdgcn_cosf(fr); cs[2 * i + 1] = __builtin_amdgcn_sinf(fr);
        }
    }
    GRID_SYNC();
    const int gb = (G >= 128) ? 64 : G;
    for (int gi = 0; gi < 4; ++gi) {
        unsigned char* ws = A.ws; unsigned char* dob = (unsigned char*)A.out; asm volatile("" : "+s"(ws), "+s"(dob));
        pg8::Gemm g; pg8::StaticOrder S; EpiUni E; E.mode = 0; E.mkv_need = (G == 256) ? 64 : 0; E.ws = ws; E.dob = dob; E.x = A.x; E.out = A.out; E.br = 0; E.fg = A.final_norm; E.xl = lds + 131072;
        bool run = true;
        switch (gi) {
            case 0: g = pg8::Gemm{(const pg8::bf16_t*)(ws + WS_MEMN), (const pg8::bf16_t*)(ws + WS_WMKVT), NB * NMEM, 2048, 2048}; E.mode = GM_MKV;
                    if (G >= 128) { run = bx >= G - gb; S.init(g.M, g.N, gb, bx - (G - gb)); } else S.init(g.M, g.N, G, bx); break;
            case 1: g = pg8::Gemm{(const pg8::bf16_t*)(ws + WS_HBF), (const pg8::bf16_t*)(ws + WS_WINT), MTOK, IN_PAD, 2048}; E.mode = GM_INPROJ; S.init(g.M, g.N, G, bx); break;
            case 2: g = pg8::Gemm{(const pg8::bf16_t*)(ws + WS_ACQ), (const pg8::bf16_t*)(ws + WS_WQT), MTOK, 1536, 512}; E.mode = GM_Q; S.init(g.M, g.N, G, bx); break;
            case 3: g = pg8::Gemm{(const pg8::bf16_t*)(ws + WS_ACKV), (const pg8::bf16_t*)(ws + WS_WKVT), MTOK, 2048, 512}; E.mode = GM_KV; S.init(g.M, g.N, G, bx); break;
            case 4: case 5: case 6: {
                const int br = gi - 4;
                const unsigned char* ap = (br == 0) ? (dob + DO_MV) : (br == 1 ? ws + WS_QN : ws + WS_CQ);
                g = pg8::Gemm{(const pg8::bf16_t*)ap, (const pg8::bf16_t*)(ws + WS_WBRT + (size_t)br * 4 * MiB), MTOK, 2048, 1024}; E.mode = GM_BR; E.br = br; S.init(g.M, g.N, G, bx); break; }
            default: g = pg8::Gemm{(const pg8::bf16_t*)(ws + WS_MERGED), (const pg8::bf16_t*)(ws + WS_WOUTT), MTOK, 2048, 2048}; E.mode = GM_OUT; S.init(g.M, g.N, G, bx); break;
        }
        if (gi == 2) {
            const int t = opaque_tid();
            for (int it = bx; it < 256; it += G) conv_item((bf16_t*)(dob + DO_QK), (const bf16_t*)(ws + WS_HALO), A.conv_w, A.conv_b, it * 2 + (t >> 8), t & 255);
        }
#ifndef NO_GEMM
        if (run) pg8::gemm_phase<EpiUni, pg8::StaticOrder, true, true>(lds, g, S, E);
#endif
        if (gi == 0) {
            if (G == 256) {
                if (run) { asm volatile("s_waitcnt vmcnt(0)" ::: "memory"); __syncthreads(); if (opaque_tid() == 0) __hip_atomic_fetch_add((unsigned*)(ws + WS_CTL) + CW_MKVDONE, 1u, __ATOMIC_RELAXED, __HIP_MEMORY_SCOPE_AGENT); }
            } else GRID_SYNC();
        }
        if (gi == 1 || gi == 6) GRID_SYNC();
    }
    {
        unsigned char* ws = A.ws; unsigned char* dob = (unsigned char*)A.out; asm volatile("" : "+s"(ws), "+s"(dob)); unsigned* ctl = (unsigned*)(ws + WS_CTL);
            GRID_SYNC();
            constexpr int U_ML = 128, U_AT = 512, U_CA = 512, U_CV = 5 * 128;
            LAS int* qslot = (LAS int*)(lds + LDS_BYTES - 16);
            for (;;) {
                const int tid = opaque_tid();
                __syncthreads();
                if (tid == 0) *qslot = (int)atomicAdd(ctl + CW_QUEUE, 1u);
                __syncthreads();
                const int ui = *qslot;
                if (ui >= U_ML + U_AT + U_CA + U_CV) break;
                if (ui < U_ML) {
                    const int vp = ui & 3, h = (ui >> 2) & 3, b = ui >> 4;
#ifndef NO_ML
                    mlstm_unit(lds, b, h, vp, (const bf16_t*)(dob + DO_QK), (const bf16_t*)(dob + DO_MV), (bf16_t*)(ws + hraw_off(b)), (const bf16_t*)(ws + WS_MISC), A.b_ig[h], A.b_fg[h]);
#endif
                } else if (ui < U_ML + U_AT) {
                    const int r = ui - U_ML, qb = 7 - (r >> 6), bh = r & 63, b = bh >> 3, h = bh & 7;
                    const size_t rowq = (size_t)b * SEQ + 256 * qb, rowk = (size_t)b * SEQ;
                    bf16_t* qn = (bf16_t*)(ws + WS_QN) + rowq * 1024 + h * 128;
#ifndef NO_AT
                    attn_unit<128, 64, 128, true, 2>(lds, qn, 1024, (const bf16_t*)(ws + WS_QR) + rowq * 512 + h * 64, 512,
                        (const bf16_t*)(ws + WS_KN) + rowk * 1024 + h * 128, 1024, (const bf16_t*)(ws + WS_MISC) + rowk * 256, 256,
                        (const bf16_t*)(ws + WS_VA) + rowk * 1024 + h * 128, 1024, (const bf16_t*)(ws + WS_AZ) + rowq * 1024 + h * 128, 1024, qn, 1024,
                        4 * qb + 4, qb, 0.07216878364870322f * 1.4426950408889634f);
#endif
                } else if (ui < U_ML + U_AT + U_CA) {
                    const int r = ui - U_ML - U_AT, qb = r & 15, bh = r >> 4, b = bh >> 2, h = bh & 3;
                    const size_t rowq = (size_t)b * SEQ + 128 * qb, rowk = (size_t)b * NMEM;
                    bf16_t* cq = (bf16_t*)(ws + WS_CQ) + rowq * 1024 + h * 256;
#ifndef NO_CA
                    attn_unit<256, 0, 256, false, 1>(lds, cq, 1024, nullptr, 0,
                        (const bf16_t*)(ws + WS_MKK) + rowk * 1024 + h * 256, 1024, nullptr, 0,
                        (const bf16_t*)(ws + WS_MKV) + rowk * 1024 + h * 256, 1024, (const bf16_t*)(ws + WS_CZ) + rowq * 1024 + h * 256, 1024, cq, 1024,
                        4, 0, 0.0625f * 1.4426950408889634f);
#endif
                } else {
                    const int lane = opaque_tid() & 63;
                    const int r = ui - U_ML - U_AT - U_CA, mat = r >> 7, item = (r & 127) * 8 + wid;
                    if (mat < 3) { const float* W = mat == 0 ? A.w_br_m : (mat == 1 ? A.w_br_a : A.w_br_c);
                        transpose_item(W, 1024, 2048, (bf16_t*)(ws + WS_WBRT + (size_t)mat * 4 * MiB), MAT_ID, nullptr, scr, item, 64, lane); }
                    else transpose_item(A.w_out, 2048, 2048, (bf16_t*)(ws + WS_WOUTT), MAT_ID, nullptr, scr, (mat - 3) * 1024 + item, 64, lane);
                }
            }
            GRID_SYNC();
            {
                const int lane = opaque_tid() & 63;
                bf16_t* mv = (bf16_t*)(dob + DO_MV); const bf16_t* mo = (const bf16_t*)(dob + DO_MO); const bf16_t* mz = (const bf16_t*)(ws + WS_MZ);
                for (int m = gw; m < MTOK; m += NGW) {
                    const size_t off = (size_t)m * 1024 + lane * 16;
                    const bf16_t* hr = (const bf16_t*)(ws + hraw_off(m >> 11)) + ((size_t)((lane >> 4) * 8 + ((lane & 15) >> 1)) * 2048 + (m & 2047)) * 32 + (lane & 1) * 16;
                    const u32x4 h0 = *(const u32x4*)hr, h1 = *(const u32x4*)(hr + 8);
                    const u32x4 o0 = *(const u32x4*)(mo + off), o1 = *(const u32x4*)(mo + off + 8);
                    const u32x4 z0 = *(const u32x4*)(mz + off), z1 = *(const u32x4*)(mz + off + 8);
                    float hv[16], ov[16], zv[16];
                    const unsigned hw[8] = {h0.x, h0.y, h0.z, h0.w, h1.x, h1.y, h1.z, h1.w}, ow[8] = {o0.x, o0.y, o0.z, o0.w, o1.x, o1.y, o1.z, o1.w}, zw[8] = {z0.x, z0.y, z0.z, z0.w, z1.x, z1.y, z1.z, z1.w};
                    float s = 0.f;
#pragma unroll
                    for (int j = 0; j < 8; ++j) { hv[2 * j] = bflo(hw[j]); hv[2 * j + 1] = bfhi(hw[j]); ov[2 * j] = bflo(ow[j]); ov[2 * j + 1] = bfhi(ow[j]); zv[2 * j] = bflo(zw[j]); zv[2 * j + 1] = bfhi(zw[j]);
                        s += hv[2 * j] * hv[2 * j] + hv[2 * j + 1] * hv[2 * j + 1]; }
                    s += __shfl_xor(s, 1); s += __shfl_xor(s, 2); s += __shfl_xor(s, 4); s += __shfl_xor(s, 8);
                    const float rstd = 1.0f / sqrtf(s * (1.0f / 256.0f) + EPS);
                    const float* gp = A.mh_norm + lane * 16;
                    unsigned ow2[8];
#pragma unroll
                    for (int j = 0; j < 8; ++j) {
                        const float a = hv[2 * j] * rstd * gp[2 * j] * sigmoidf_(ov[2 * j]) * siluf_(zv[2 * j]);
                        const float bq = hv[2 * j + 1] * rstd * gp[2 * j + 1] * sigmoidf_(ov[2 * j + 1]) * siluf_(zv[2 * j + 1]);
                        ow2[j] = pk2(a, bq);
                    }
                    *(u32x4*)(mv + off) = (u32x4){ow2[0], ow2[1], ow2[2], ow2[3]};
                    *(u32x4*)(mv + off + 8) = (u32x4){ow2[4], ow2[5], ow2[6], ow2[7]};
                }
            }
            GRID_SYNC();

    }
    for (int gi = 4; gi < 8; ++gi) {
        unsigned char* ws = A.ws; unsigned char* dob = (unsigned char*)A.out; asm volatile("" : "+s"(ws), "+s"(dob));
        pg8::Gemm g; pg8::StaticOrder S; EpiUni E; E.mode = 0; E.mkv_need = (G == 256) ? 64 : 0; E.ws = ws; E.dob = dob; E.x = A.x; E.out = A.out; E.br = 0; E.fg = A.final_norm; E.xl = lds + 131072;
        bool run = true;
        switch (gi) {
            case 0: g = pg8::Gemm{(const pg8::bf16_t*)(ws + WS_MEMN), (const pg8::bf16_t*)(ws + WS_WMKVT), NB * NMEM, 2048, 2048}; E.mode = GM_MKV;
                    if (G >= 128) { run = bx >= G - gb; S.init(g.M, g.N, gb, bx - (G - gb)); } else S.init(g.M, g.N, G, bx); break;
            case 1: g = pg8::Gemm{(const pg8::bf16_t*)(ws + WS_HBF), (const pg8::bf16_t*)(ws + WS_WINT), MTOK, IN_PAD, 2048}; E.mode = GM_INPROJ; S.init(g.M, g.N, G, bx); break;
            case 2: g = pg8::Gemm{(const pg8::bf16_t*)(ws + WS_ACQ), (const pg8::bf16_t*)(ws + WS_WQT), MTOK, 1536, 512}; E.mode = GM_Q; S.init(g.M, g.N, G, bx); break;
            case 3: g = pg8::Gemm{(const pg8::bf16_t*)(ws + WS_ACKV), (const pg8::bf16_t*)(ws + WS_WKVT), MTOK, 2048, 512}; E.mode = GM_KV; S.init(g.M, g.N, G, bx); break;
            case 4: case 5: case 6: {
                const int br = gi - 4;
                const unsigned char* ap = (br == 0) ? (dob + DO_MV) : (br == 1 ? ws + WS_QN : ws + WS_CQ);
                g = pg8::Gemm{(const pg8::bf16_t*)ap, (const pg8::bf16_t*)(ws + WS_WBRT + (size_t)br * 4 * MiB), MTOK, 2048, 1024}; E.mode = GM_BR; E.br = br; S.init(g.M, g.N, G, bx); break; }
            default: g = pg8::Gemm{(const pg8::bf16_t*)(ws + WS_MERGED), (const pg8::bf16_t*)(ws + WS_WOUTT), MTOK, 2048, 2048}; E.mode = GM_OUT; S.init(g.M, g.N, G, bx); break;
        }
#ifndef NO_GEMM
        if (gi == 4) {
            g.dA1 = (const char*)(ws + WS_QN) - (const char*)g.A; g.dA2 = (long)WS_CQ - (long)WS_QN; g.dB1 = (long)(4 * MiB); g.dB2 = (long)(4 * MiB);
            S.chain = 1; E.mode = GM_BRC; pg8::gemm_phase<EpiUni, pg8::StaticOrder, true, true>(lds, g, S, E);
        } else if (gi == 5 || gi == 6) {
        } else
        if (gi == 7 && G == 256) {
            E.mode = GM_OUTF;
            S.prow = 0; pg8::gemm_phase<EpiUni, pg8::StaticOrder, true, true>(lds, g, S, E);
            S.prow = 1; pg8::gemm_phase<EpiUni, pg8::StaticOrder, true, true>(lds, g, S, E);
        } else
        if (run) pg8::gemm_phase<EpiUni, pg8::StaticOrder, true, true>(lds, g, S, E);
#endif
        if (gi == 0 || gi == 1 || gi == 6) GRID_SYNC();
    }
    if (G == 256) return;
    GRID_SYNC();
    const int lane = opaque_tid() & 63;
    for (int m = gw; m < MTOK; m += NGW) {
        f32x4* xr = (f32x4*)(A.out + (size_t)m * DM) + lane;
        f32x4 v[8]; float s = 0.f;
#pragma unroll
        for (int j = 0; j < 8; ++j) { v[j] = xr[64 * j]; s += (v[j][0] * v[j][0] + v[j][1] * v[j][1]) + (v[j][2] * v[j][2] + v[j][3] * v[j][3]); }
        const float rstd = 1.0f / sqrtf(wave_sum(s) * (1.0f / 2048.0f) + EPS);
        const f32x4* gr = (const f32x4*)A.final_norm + lane;
#pragma unroll
        for (int j = 0; j < 8; ++j) xr[64 * j] = v[j] * rstd * gr[64 * j];
    }
}

extern "C" void kernel_launch(void* const* d_in, const int* in_sizes, int n_in, void* d_out, int out_size, void* d_ws, size_t ws_size, hipStream_t stream) {
    static int grid = 0;
    if (grid == 0) {
        if (n_in != 21 || ws_size < WS_NEED) { fprintf(stderr, "kernel_launch: unexpected inputs (n_in %d, ws %zu)\n", n_in, ws_size); grid = -1; return; }
        int dev = 0, cus = 0, per_cu = 0;
        hipGetDevice(&dev);
        hipDeviceGetAttribute(&cus, hipDeviceAttributeMultiprocessorCount, dev);
        if (hipFuncSetAttribute((const void*)fwd_megakernel, hipFuncAttributeMaxDynamicSharedMemorySize, LDS_BYTES) != hipSuccess) { fprintf(stderr, "kernel_launch: hipFuncSetAttribute failed\n"); grid = -1; return; }
        hipOccupancyMaxActiveBlocksPerMultiprocessor(&per_cu, (const void*)fwd_megakernel, NTHR, LDS_BYTES);
        (void)hipGetLastError();
        if (per_cu < 1) per_cu = 1;
        grid = cus * 1;
        if (grid <= 0) { grid = -1; return; }
    }
    if (grid < 0) return;
    Args a{};
    a.x = (const float*)d_in[0]; a.mem = (const float*)d_in[1]; a.pos = (const int*)d_in[2]; a.w_in = (const float*)d_in[3]; a.b_ig = (const float*)d_in[4]; a.b_fg = (const float*)d_in[5];
    a.conv_w = (const float*)d_in[6]; a.conv_b = (const float*)d_in[7]; a.mh_norm = (const float*)d_in[8]; a.cq_norm = (const float*)d_in[9]; a.w_uq = (const float*)d_in[10];
    a.ckv_norm = (const float*)d_in[11]; a.w_ukv = (const float*)d_in[12]; a.mem_norm = (const float*)d_in[13]; a.w_mem_kv = (const float*)d_in[14];
    a.w_br_m = (const float*)d_in[15]; a.w_br_a = (const float*)d_in[16]; a.w_br_c = (const float*)d_in[17]; a.w_out = (const float*)d_in[18]; a.norm = (const float*)d_in[19]; a.final_norm = (const float*)d_in[20];
    a.out = (float*)d_out; a.ws = (unsigned char*)d_ws;
    if (hipMemsetAsync(d_ws, 0, CTL_ZERO_BYTES, stream) != hipSuccess) { fprintf(stderr, "memset failed\n"); return; }
    void* args[] = {&a};
    hipError_t e = hipLaunchCooperativeKernel((const void*)fwd_megakernel, dim3(grid), dim3(NTHR), args, LDS_BYTES, stream);
    if (e != hipSuccess) fprintf(stderr, "cooperative launch failed: %s (grid %d)\n", hipGetErrorString(e), grid);
}
```
